# Optimizing an MI355X kernel written in HIP

```python
import jax, jax.numpy as jnp
from jax import lax
import numpy as np

D_MODEL = 1024
BATCH = 16
SEQ = 4096
DEPTH = 2

N_MIXERS = 2
PLE_DIM = 256
D_FF = 4 * D_MODEL
EPS = 1e-6

HG_KDIM = 128
HG_HEADS = D_MODEL // HG_KDIM
HG_VDIM = D_MODEL // HG_HEADS
HG_QK = HG_HEADS * HG_KDIM
HG_V = HG_HEADS * HG_VDIM
HG_CHUNK = 64
N_HGRN = (DEPTH + 1) // 2

MLA_HEADS = 16
MLA_Q_RANK = 384
MLA_KV_RANK = 256
MLA_NOPE = 128
MLA_ROPE = 64
MLA_V = 128
ROPE_BASE = 10000.0
Q_BLOCK = 128
N_MLA = DEPTH // 2

kernel_name = "hybrid_hgrn2_mla_encoder"


def rms_norm(x, gain):
    xf = x.astype(jnp.float32)
    y = xf * lax.rsqrt(jnp.mean(xf * xf, axis=-1, keepdims=True) + EPS)
    return (y * gain.astype(jnp.float32)).astype(x.dtype)


def gla_chunk_scan(q, k, v, g):
    b, h, s, dk = q.shape
    dv = v.shape[-1]
    nc = s // HG_CHUNK

    def to_chunks(t):
        return jnp.moveaxis(t.reshape(b, h, nc, HG_CHUNK, t.shape[-1]), 2, 0)

    qc, kc, vc, gc = to_chunks(q), to_chunks(k), to_chunks(v), to_chunks(g)
    mask = jnp.tril(jnp.ones((HG_CHUNK, HG_CHUNK), dtype=bool))

    def step(state, inp):
        qi, ki, vi, gi = inp
        G = jnp.cumsum(gi.astype(jnp.float32), axis=-2)
        G_last = G[..., -1:, :]
        q_dec = qi * jnp.exp(G)
        k_inv = ki * jnp.exp(-G)
        k_end = ki * jnp.exp(G_last - G)
        attn = jnp.where(mask, jnp.einsum('bhik,bhjk->bhij', q_dec, k_inv), 0.0)
        o = (jnp.einsum('bhij,bhjv->bhiv', attn, vi)
             + jnp.einsum('bhik,bhkv->bhiv', q_dec, state))
        new_state = (jnp.exp(G_last[..., 0, :])[..., None] * state
                     + jnp.einsum('bhjk,bhjv->bhkv', k_end, vi))
        return new_state, o

    state0 = jnp.zeros((b, h, dk, dv), jnp.float32)
    _, o = lax.scan(step, state0, (qc, kc, vc, gc))
    return jnp.moveaxis(o, 0, 2).reshape(b, h, s, dv).astype(v.dtype)


def hgrn2_mixer(x, w_in, o_norm, w_out, lb):
    b, s, _ = x.shape
    proj = x @ w_in
    q, f_fw, f_bw, inp, gate = jnp.split(
        proj, [HG_QK, 2 * HG_QK, 3 * HG_QK, 3 * HG_QK + HG_V], axis=-1)

    def heads(t):
        return jnp.transpose(t.reshape(b, s, HG_HEADS, -1), (0, 2, 1, 3))

    q = heads(q) * (HG_KDIM ** -0.5)
    v = heads(inp)
    lbh = lb.astype(jnp.float32).reshape(HG_HEADS, 1, HG_KDIM)

    def gates(f_logit):
        f = lbh + (1.0 - lbh) * jax.nn.sigmoid(heads(f_logit).astype(jnp.float32))
        return 1.0 - f, jnp.log(f)

    k_f, g_f = gates(f_fw)
    k_b, g_b = gates(f_bw)
    flip = lambda t: jnp.flip(t, axis=2)
    o_f = gla_chunk_scan(q, k_f, v, g_f)
    o_b = flip(gla_chunk_scan(flip(q), flip(k_b), flip(v), flip(g_b)))
    o = rms_norm(o_f + o_b, o_norm[:, None, :])
    o = jnp.transpose(o, (0, 2, 1, 3)).reshape(b, s, HG_V)
    return (o * jax.nn.silu(gate)) @ w_out


def rope_angles(positions, dim):
    inv = 1.0 / (ROPE_BASE ** (jnp.arange(0, dim, 2, dtype=jnp.float32) / dim))
    ang = positions.astype(jnp.float32)[..., None] * inv
    return jnp.cos(ang), jnp.sin(ang)


def apply_rope(t, cos, sin):
    t1, t2 = jnp.split(t, 2, axis=-1)
    cos = cos.astype(t.dtype)
    sin = sin.astype(t.dtype)
    return jnp.concatenate([t1 * cos - t2 * sin, t1 * sin + t2 * cos], axis=-1)


def mla_mixer(x, positions, w_in, q_norm, w_uq, kv_norm, w_ukv, w_o):
    b, s, _ = x.shape
    proj = x @ w_in
    cq, ckv, k_rope = jnp.split(proj, [MLA_Q_RANK, MLA_Q_RANK + MLA_KV_RANK], axis=-1)
    cq = rms_norm(cq, q_norm)
    ckv = rms_norm(ckv, kv_norm)
    q = (cq @ w_uq).reshape(b, s, MLA_HEADS, MLA_NOPE + MLA_ROPE)
    q_nope, q_rope = q[..., :MLA_NOPE], q[..., MLA_NOPE:]
    cos, sin = rope_angles(positions, MLA_ROPE)
    q_rope = apply_rope(q_rope, cos[:, :, None, :], sin[:, :, None, :])
    k_rope = apply_rope(k_rope, cos, sin)
    w_ukv_h = w_ukv.reshape(MLA_KV_RANK, MLA_HEADS, MLA_NOPE + MLA_V)
    w_uk, w_uv = w_ukv_h[..., :MLA_NOPE], w_ukv_h[..., MLA_NOPE:]
    q_lat = jnp.einsum('bshn,chn->bshc', q_nope, w_uk)
    scale = (MLA_NOPE + MLA_ROPE) ** -0.5
    nb = s // Q_BLOCK

    def blockify(t):
        return jnp.moveaxis(t.reshape(b, nb, Q_BLOCK, *t.shape[2:]), 1, 0)

    def attend(blk):
        ql, qr = blk
        scores = (jnp.einsum('bqhc,bkc->bhqk', ql, ckv)
                  + jnp.einsum('bqhr,bkr->bhqk', qr, k_rope)) * scale
        probs = jax.nn.softmax(scores.astype(jnp.float32), axis=-1).astype(ckv.dtype)
        return jnp.einsum('bhqk,bkc->bqhc', probs, ckv)

    o_lat = lax.map(attend, (blockify(q_lat), blockify(q_rope)))
    o_lat = jnp.moveaxis(o_lat, 0, 1).reshape(b, s, MLA_HEADS, MLA_KV_RANK)
    o = jnp.einsum('bshc,chv->bshv', o_lat, w_uv).reshape(b, s, MLA_HEADS * MLA_V)
    return o @ w_o


def squared_relu_mlp(x, w1, w2):
    return jnp.square(jax.nn.relu(x @ w1)) @ w2


def setup_inputs(seed: int = 0) -> dict:
    key = jax.random.key(seed)
    ks = jax.random.split(key, 32)
    f32 = jnp.float32

    def nrm(k, shape, fan_in):
        return jax.random.normal(k, shape, f32) * (fan_in ** -0.5)

    def gain(k, shape):
        return 1.0 + 0.05 * jax.random.normal(k, shape, f32)

    x = jax.random.normal(ks[0], (BATCH, SEQ, D_MODEL), f32)
    p = jax.random.normal(ks[1], (DEPTH, BATCH, SEQ, PLE_DIM), f32)
    positions = (jnp.arange(SEQ, dtype=jnp.int32)[None, :]
                 + jax.random.randint(ks[2], (BATCH, 1), 0, SEQ, dtype=jnp.int32))
    return {
        "x": x,
        "p": p,
        "positions": positions,
        "pre_mix_norm": gain(ks[3], (DEPTH, D_MODEL)),
        "post_mix_norm": gain(ks[4], (DEPTH, D_MODEL)),
        "pre_mlp_norm": gain(ks[5], (DEPTH, D_MODEL)),
        "post_mlp_norm": gain(ks[6], (DEPTH, D_MODEL)),
        "w_mlp_in": nrm(ks[7], (DEPTH, D_MODEL, D_FF), D_MODEL),
        "w_mlp_out": nrm(ks[8], (DEPTH, D_FF, D_MODEL), D_FF),
        "w_ple_proj": nrm(ks[9], (DEPTH, PLE_DIM, D_MODEL), PLE_DIM),
        "w_ple_gate": nrm(ks[10], (DEPTH, D_MODEL, D_MODEL), D_MODEL),
        "ple_norm": gain(ks[11], (DEPTH, D_MODEL)),
        "hg_lb_logits": 0.1 * jax.random.normal(ks[12], (DEPTH + 1, HG_QK), f32),
        "hg_w_in": nrm(ks[13], (N_HGRN, D_MODEL, 3 * HG_QK + 2 * HG_V), D_MODEL),
        "hg_o_norm": gain(ks[14], (N_HGRN, HG_HEADS, HG_VDIM)),
        "hg_w_out": nrm(ks[15], (N_HGRN, HG_V, D_MODEL), HG_V),
        "mla_w_in": nrm(ks[16], (N_MLA, D_MODEL, MLA_Q_RANK + MLA_KV_RANK + MLA_ROPE), D_MODEL),
        "mla_q_norm": gain(ks[17], (N_MLA, MLA_Q_RANK)),
        "mla_w_uq": nrm(ks[18], (N_MLA, MLA_Q_RANK, MLA_HEADS * (MLA_NOPE + MLA_ROPE)), MLA_Q_RANK),
        "mla_kv_norm": gain(ks[19], (N_MLA, MLA_KV_RANK)),
        "mla_w_ukv": nrm(ks[20], (N_MLA, MLA_KV_RANK, MLA_HEADS * (MLA_NOPE + MLA_V)), MLA_KV_RANK),
        "mla_w_o": nrm(ks[21], (N_MLA, MLA_HEADS * MLA_V, D_MODEL), MLA_HEADS * MLA_V),
    }


def reference(x, p, positions, pre_mix_norm, post_mix_norm, pre_mlp_norm, post_mlp_norm,
              w_mlp_in, w_mlp_out, w_ple_proj, w_ple_gate, ple_norm,
              hg_lb_logits, hg_w_in, hg_o_norm, hg_w_out,
              mla_w_in, mla_q_norm, mla_w_uq, mla_kv_norm, mla_w_ukv, mla_w_o):
    lb_all = jnp.cumsum(jax.nn.softmax(hg_lb_logits.astype(jnp.float32), axis=0), axis=0)
    h = x
    for i in range(DEPTH):
        a = rms_norm(h, pre_mix_norm[i])
        j = i // N_MIXERS
        if i % N_MIXERS == 0:
            m = hgrn2_mixer(a, hg_w_in[j], hg_o_norm[j], hg_w_out[j], lb_all[i])
        else:
            m = mla_mixer(a, positions, mla_w_in[j], mla_q_norm[j], mla_w_uq[j],
                          mla_kv_norm[j], mla_w_ukv[j], mla_w_o[j])
        h = h + rms_norm(m, post_mix_norm[i])
        f = squared_relu_mlp(rms_norm(h, pre_mlp_norm[i]), w_mlp_in[i], w_mlp_out[i])
        h = h + rms_norm(f, post_mlp_norm[i])
        e = p[i].astype(h.dtype) @ w_ple_proj[i]
        g = jax.nn.sigmoid(h @ w_ple_gate[i])
        h = h + rms_norm(g * e, ple_norm[i])
    return h
```

```cpp
#include <hip/hip_runtime.h>
#include <hip/hip_cooperative_groups.h>
#include <cstdio>
#include <cstdint>
namespace cg = cooperative_groups;
namespace pg8 {
#define PG8_LAS __attribute__((address_space(3)))
typedef unsigned short bf16_t;
typedef short bf16x8 __attribute__((ext_vector_type(8)));
typedef float f32x4 __attribute__((ext_vector_type(4)));
typedef unsigned u32x4 __attribute__((ext_vector_type(4)));
constexpr int BM = 256, BK = 64, HALF = 128, HTB = HALF * BK * 2  , STAGE_BYTES = 8 * HTB, NXCD = 8, WGM = 4;

__host__ __device__ __forceinline__ int lds_byte(int r, int c) { const int st = (r >> 4) * 2 + (c >> 5), rr = r & 15, cc = c & 31, ob = rr * 64 + cc * 2; return st * 1024 + (ob ^ (((ob >> 9) & 1) << 5)); }
__host__ __device__ __forceinline__ void stage_rc(int b, int& R, int& C) { const int st = b / 1024, sb = b % 1024, swz = sb ^ (((sb >> 9) & 1) << 5); R = (st >> 1) * 16 + swz / 64; C = (st & 1) * 32 + (swz % 64) / 2; }
__host__ __device__ __forceinline__ int perm32(int rho) { const int n = rho >> 4, i = rho & 15; return 8 * (i >> 2) + 4 * n + (i & 3); }

struct Unit { int pm, pn; };
struct Gemm { const bf16_t* A; const bf16_t* Bt; int M, N, K; };

struct StaticOrder {
    int nM, nN, nwg, G, c;
    __host__ __device__ void init(int M, int N, int G_, int c_) { nM = M / BM; nN = N / BM; nwg = nM * nN; G = G_; c = c_; }
    __host__ __device__ bool next(int i, Unit& u) const {
        const long L = (long)i * G + c; if (L >= nwg) return false;
        int wgid = (int)L; { const int q = nwg / NXCD, r = nwg % NXCD, xcd = wgid % NXCD, off = wgid / NXCD; wgid = (xcd < r ? xcd * (q + 1) : r * (q + 1) + (xcd - r) * q) + off; }
        const int nig = WGM * nN, gid = wgid / nig, fm = gid * WGM, gsz = (nM - fm) < WGM ? (nM - fm) : WGM;
        u.pm = fm + ((wgid % nig) % gsz); u.pn = (wgid % nig) / gsz; return true;
    }
    __device__ __forceinline__ void a_ready(const Unit&) const {}
    __device__ __forceinline__ void done(const Unit&) const {}
};

__device__ __forceinline__ unsigned cvt_pk_bf16(float lo, float hi) { unsigned r; asm volatile("v_cvt_pk_bf16_f32 %0, %1, %2" : "=v"(r) : "v"(lo), "v"(hi)); return r; }
typedef float f32x2_t __attribute__((ext_vector_type(2))); typedef __bf16 bf16x2_t __attribute__((ext_vector_type(2)));
__device__ __forceinline__ unsigned cvt_pk_safe(float lo, float hi) { f32x2_t v = {lo, hi}; bf16x2_t b = __builtin_convertvector(v, bf16x2_t); return __builtin_bit_cast(unsigned, b); }
template <int mode> struct EpiGen {
    static constexpr bool PERM = true, AFTER_DRAIN = false;
    bf16_t* O; int ldc; float* part; const bf16_t* E;
    __device__ __forceinline__ void operator()(const f32x4 (&acc)[2][2][4][2], const Unit& u, int wr, int wc, int fr, int fq) const {
        const int row0 = u.pm * BM + wr * 64 + fr, col0 = u.pn * BM + wc * 32 + 8 * fq;
#pragma unroll
        for (int ai = 0; ai < 2; ++ai)
#pragma unroll
            for (int m = 0; m < 4; ++m) {
                const int row = row0 + ai * HALF + m * 16;
                bf16_t* rowp = O + (size_t)row * ldc + col0;
                float ss = 0.f;
#pragma unroll
                for (int bj = 0; bj < 2; ++bj) {
                    f32x4 v0 = acc[ai][bj][m][0], v1 = acc[ai][bj][m][1];
                    if (mode == 1) {
#pragma unroll
                        for (int i = 0; i < 4; ++i) { float a = fmaxf(v0[i], 0.f), b = fmaxf(v1[i], 0.f); v0[i] = a * a; v1[i] = b * b; }
                    } else if (mode == 3) {
                        const u32x4 e = *(const u32x4*)(E + (size_t)row * ldc + col0 + bj * HALF);
                        float ef[8];
#pragma unroll
                        for (int i = 0; i < 4; ++i) { ef[2 * i] = __uint_as_float(e[i] << 16); ef[2 * i + 1] = __uint_as_float(e[i] & 0xffff0000u); }
#pragma unroll
                        for (int i = 0; i < 4; ++i) { v0[i] = ef[i] / (1.f + __expf(-v0[i])); v1[i] = ef[4 + i] / (1.f + __expf(-v1[i])); }
                    }
                    if (mode >= 2) ss += (v0[0] * v0[0] + v0[1] * v0[1]) + (v0[2] * v0[2] + v0[3] * v0[3]) + (v1[0] * v1[0] + v1[1] * v1[1]) + (v1[2] * v1[2] + v1[3] * v1[3]);
                    u32x4 w; w.x = cvt_pk_safe(v0[0], v0[1]); w.y = cvt_pk_safe(v0[2], v0[3]); w.z = cvt_pk_safe(v1[0], v1[1]); w.w = cvt_pk_safe(v1[2], v1[3]);
                    *(u32x4*)(rowp + bj * HALF) = w;
                }
                if (mode >= 2) { ss += __shfl_xor(ss, 16); ss += __shfl_xor(ss, 32); if (fq == 0) part[(size_t)row * 16 + u.pn * 4 + wc] = ss; }
            }
    }
};
template <class Epi, class Sched, bool ALIGN_EPI = false, bool SP2 = false>
__device__ __forceinline__ void gemm_phase(PG8_LAS unsigned char* lds, const Gemm g, const Sched& S, const Epi& E) {
    const int tid = threadIdx.x, wid = __builtin_amdgcn_readfirstlane(tid >> 6), lane = tid & 63, wr = wid >> 2, wc = wid & 3, fr = lane & 15, fq = lane >> 4;
    const int K = g.K, nt = K / BK;
    unsigned voffA[2], voffB[2];
#pragma unroll
    for (int i = 0; i < 2; ++i) { int R, C; stage_rc(tid * 16 + i * 8192, R, C); const int Rb = Epi::PERM ? ((R & ~31) + perm32(R & 31)) : R;
        voffA[i] = (unsigned)(R * K + C) * 2u; voffB[i] = (unsigned)(Rb * K + C) * 2u; }
    const size_t kstep = (size_t)(BK * 2);
    const size_t hstep = (size_t)HALF * K * 2;
    const size_t tstep = 2 * hstep;
    const unsigned ldsw = (unsigned)wid * 1024u;
    const int aoff = lds_byte(wr * 64 + fr, fq * 8), boff = lds_byte(wc * 32 + fr, fq * 8);
#define PG8_SA(b, h) (((b) * 2 + (h)) * HTB)
#define PG8_SB(b, h) ((4 + (b) * 2 + (h)) * HTB)
#define PG8_STAGE(bufoff, gbase, voff) do { _Pragma("unroll") for (int _i = 0; _i < 2; ++_i) \
        __builtin_amdgcn_global_load_lds((const unsigned*)((const char*)(gbase) + (voff)[_i]), (PG8_LAS unsigned*)(lds + (bufoff) + ldsw + _i * 8192), 16, 0, 0); } while (0)
#define PG8_LDA(dst, b, h) do { _Pragma("unroll") for (int m = 0; m < 4; ++m) _Pragma("unroll") for (int k = 0; k < 2; ++k) dst[m][k] = *(const PG8_LAS bf16x8*)(lds + PG8_SA(b, h) + aoff + m * 2048 + k * 1024); } while (0)
#define PG8_LDB(dst, b, h) do { _Pragma("unroll") for (int n = 0; n < 2; ++n) _Pragma("unroll") for (int k = 0; k < 2; ++k) dst[n][k] = *(const PG8_LAS bf16x8*)(lds + PG8_SB(b, h) + boff + n * 2048 + k * 1024); } while (0)
#define PG8_MMA(ai, bj, At, Bt) do { __builtin_amdgcn_s_setprio(1); _Pragma("unroll") for (int m = 0; m < 4; ++m) _Pragma("unroll") for (int n = 0; n < 2; ++n) _Pragma("unroll") for (int k = 0; k < 2; ++k) \
        acc[ai][bj][m][n] = __builtin_amdgcn_mfma_f32_16x16x32_bf16(Bt[n][k], At[m][k], acc[ai][bj][m][n], 0, 0, 0); __builtin_amdgcn_s_setprio(0); } while (0)
#define PG8_WAIT_V(n) asm volatile("s_waitcnt vmcnt(" #n ")" ::: "memory")
#define PG8_WAIT_L(n) asm volatile("s_waitcnt lgkmcnt(" #n ")" ::: "memory")
#define PG8_BAR __builtin_amdgcn_s_barrier()
#define PG8_SCHED __builtin_amdgcn_sched_barrier(0)
    Unit cur, nxt; int ui = 0;
    if (!S.next(0, cur)) return;
    f32x4 acc[2][2][4][2];
#pragma unroll
    for (int a = 0; a < 2; ++a)
#pragma unroll
        for (int b = 0; b < 2; ++b)
#pragma unroll
            for (int m = 0; m < 4; ++m)
#pragma unroll
                for (int n = 0; n < 2; ++n) acc[a][b][m][n] = (f32x4){0.f, 0.f, 0.f, 0.f};
    bf16x8 At[4][2], B0[2][2], B1[2][2];
    const char* cA = (const char*)g.A + (size_t)cur.pm * tstep; const char* cB = (const char*)g.Bt + (size_t)cur.pn * tstep;
    S.a_ready(cur);
    if constexpr (SP2) {
        PG8_STAGE(PG8_SB(0, 0), cB, voffB); PG8_STAGE(PG8_SB(0, 1), cB + hstep, voffB); PG8_STAGE(PG8_SA(0, 0), cA, voffA); PG8_STAGE(PG8_SA(0, 1), cA + hstep, voffA);
        if (wr == 1) PG8_BAR;
        PG8_WAIT_V(2); PG8_BAR;
        PG8_STAGE(PG8_SB(1, 0), cB + kstep, voffB); PG8_STAGE(PG8_SA(1, 0), cA + kstep, voffA); PG8_STAGE(PG8_SB(1, 1), cB + hstep + kstep, voffB);
        PG8_WAIT_V(6); PG8_BAR;
    } else {
        PG8_STAGE(PG8_SB(0, 0), cB, voffB); PG8_STAGE(PG8_SA(0, 0), cA, voffA); PG8_STAGE(PG8_SB(0, 1), cB + hstep, voffB); PG8_STAGE(PG8_SA(0, 1), cA + hstep, voffA);
        if (wr == 1) PG8_BAR;
        PG8_WAIT_V(4); PG8_BAR;
        PG8_STAGE(PG8_SB(1, 0), cB + kstep, voffB); PG8_STAGE(PG8_SA(1, 0), cA + kstep, voffA); PG8_STAGE(PG8_SB(1, 1), cB + hstep + kstep, voffB);
        PG8_WAIT_V(6); PG8_BAR;
    }
    for (;;) {
        const bool has_next = S.next(ui + 1, nxt);
        const char* nA = has_next ? (const char*)g.A + (size_t)nxt.pm * tstep : cA; const char* nB = has_next ? (const char*)g.Bt + (size_t)nxt.pn * tstep : cB;
        for (int t = 0; t < nt; t += 2) {
            const bool last = (t == nt - 2);
            const char* a1 = cA + (size_t)(t + 1) * kstep;
            const char* a2 = last ? nA : cA + (size_t)(t + 2) * kstep; const char* b2 = last ? nB : cB + (size_t)(t + 2) * kstep;
            const char* a3 = a2 + kstep; const char* b3 = b2 + kstep;
            if (last && has_next) S.a_ready(nxt);
            if constexpr (SP2) {
            PG8_LDB(B0, 0, 0); PG8_LDB(B1, 0, 1); PG8_SCHED; PG8_LDA(At, 0, 0); PG8_STAGE(PG8_SA(1, 1), a1 + hstep, voffA);
            PG8_WAIT_V(8); PG8_WAIT_L(0); PG8_BAR; PG8_MMA(0, 0, At, B0); PG8_MMA(0, 1, At, B1); PG8_BAR; PG8_SCHED;
            PG8_LDA(At, 0, 1); PG8_STAGE(PG8_SB(0, 0), b2, voffB); PG8_STAGE(PG8_SB(0, 1), b2 + hstep, voffB); PG8_STAGE(PG8_SA(0, 0), a2, voffA);
            PG8_WAIT_V(8); PG8_WAIT_L(0); PG8_BAR; PG8_MMA(1, 0, At, B0); PG8_MMA(1, 1, At, B1); PG8_BAR; PG8_SCHED;
            PG8_LDB(B0, 1, 0); PG8_LDB(B1, 1, 1); PG8_SCHED; PG8_LDA(At, 1, 0); PG8_STAGE(PG8_SA(0, 1), a2 + hstep, voffA);
            PG8_WAIT_V(8); PG8_WAIT_L(0); PG8_BAR; PG8_MMA(0, 0, At, B0); PG8_MMA(0, 1, At, B1); PG8_BAR; PG8_SCHED;
            PG8_LDA(At, 1, 1); PG8_STAGE(PG8_SB(1, 0), b3, voffB); PG8_STAGE(PG8_SB(1, 1), b3 + hstep, voffB); PG8_STAGE(PG8_SA(1, 0), a3, voffA);
            PG8_WAIT_V(8); PG8_WAIT_L(0); PG8_BAR; PG8_MMA(1, 0, At, B0); PG8_MMA(1, 1, At, B1); PG8_BAR; PG8_SCHED;
            } else {
            PG8_LDB(B0, 0, 0); PG8_SCHED; PG8_LDA(At, 0, 0); PG8_STAGE(PG8_SA(1, 1), a1 + hstep, voffA);
            PG8_WAIT_L(8); PG8_BAR; PG8_WAIT_L(0); PG8_MMA(0, 0, At, B0); PG8_BAR; PG8_SCHED;
            PG8_LDB(B1, 0, 1); PG8_STAGE(PG8_SB(0, 0), b2, voffB);
            PG8_BAR; PG8_WAIT_L(0); PG8_MMA(0, 1, At, B1); PG8_BAR;
            PG8_LDA(At, 0, 1); PG8_STAGE(PG8_SA(0, 0), a2, voffA);
            PG8_BAR; PG8_WAIT_L(0); PG8_MMA(1, 0, At, B0); PG8_BAR; PG8_SCHED;
            PG8_STAGE(PG8_SB(0, 1), b2 + hstep, voffB);
            PG8_WAIT_V(6); PG8_BAR; PG8_MMA(1, 1, At, B1); PG8_BAR;
            PG8_LDB(B0, 1, 0); PG8_SCHED; PG8_LDA(At, 1, 0); PG8_STAGE(PG8_SA(0, 1), a2 + hstep, voffA);
            PG8_WAIT_L(8); PG8_BAR; PG8_WAIT_L(0); PG8_MMA(0, 0, At, B0); PG8_BAR; PG8_SCHED;
            PG8_LDB(B1, 1, 1); PG8_STAGE(PG8_SB(1, 0), b3, voffB);
            PG8_BAR; PG8_WAIT_L(0); PG8_MMA(0, 1, At, B1); PG8_BAR;
            PG8_LDA(At, 1, 1); PG8_STAGE(PG8_SA(1, 0), a3, voffA);
            PG8_BAR; PG8_WAIT_L(0); PG8_MMA(1, 0, At, B0); PG8_BAR; PG8_SCHED;
            PG8_STAGE(PG8_SB(1, 1), b3 + hstep, voffB);
            PG8_WAIT_V(6); PG8_BAR; PG8_MMA(1, 1, At, B1); PG8_BAR;
            }
        }
        if constexpr (ALIGN_EPI) { if (wr == 0) PG8_BAR; }
        if constexpr (!Epi::AFTER_DRAIN) { E(acc, cur, wr, wc, fr, fq); S.done(cur); }
        if (!has_next) break;
#pragma unroll
        for (int a = 0; a < 2; ++a)
#pragma unroll
            for (int b = 0; b < 2; ++b)
#pragma unroll
                for (int m = 0; m < 4; ++m)
#pragma unroll
                    for (int n = 0; n < 2; ++n) acc[a][b][m][n] = (f32x4){0.f, 0.f, 0.f, 0.f};
        cur = nxt; cA = nA; cB = nB; ++ui;
        if constexpr (ALIGN_EPI) { if (wr == 1) PG8_BAR; }
    }
    PG8_WAIT_V(0);
    if constexpr (!ALIGN_EPI) { if (wr == 0) PG8_BAR; }
    PG8_BAR;
    if constexpr (Epi::AFTER_DRAIN) { E.fused(acc, cur, wr, wc, fr, fq, lds, wid, lane); S.done(cur); }
#undef PG8_SA
#undef PG8_SB
#undef PG8_STAGE
#undef PG8_LDA
#undef PG8_LDB
#undef PG8_MMA
#undef PG8_WAIT_V
#undef PG8_WAIT_L
#undef PG8_BAR
#undef PG8_SCHED
}
}
namespace att {
typedef unsigned short bf16_t;
using bf16x8 = __attribute__((ext_vector_type(8))) short;
using s16x4  = __attribute__((ext_vector_type(4))) short;
using f32x16 = __attribute__((ext_vector_type(16))) float;
using u32x4  = __attribute__((ext_vector_type(4))) unsigned;
constexpr int NW = 8, QBLK = 32, KVBLK = 64;
constexpr float SCALE = 0.07216878364870323f;
constexpr float THR = 8.f;
#ifndef ATT_SDEPTH
#define ATT_SDEPTH 1
#endif
constexpr int SDEPTH = ATT_SDEPTH;
constexpr int LDQ = 3072, LDK = 4096, LDKR = 64, LDO = 2048;
constexpr int SHM_V = KVBLK * 128 * 2, SHM_K = KVBLK * 400, SHM_QR = 2 * SHM_V + 2 * SHM_K + NW * 64 * 4, SHM_ATTN = SHM_QR + NW * 4096;
#define KSWZ(row, colB) ((row) * 400 + (colB))
#define SBAR() __builtin_amdgcn_sched_barrier(0)
__device__ __forceinline__ int crow(int r, int hi) { return (r & 3) + 8 * (r >> 2) + 4 * hi; }
__device__ __forceinline__ unsigned cvtpk(float lo, float hi) { unsigned r; asm volatile("v_cvt_pk_bf16_f32 %0, %1, %2" : "=v"(r) : "v"(lo), "v"(hi)); return r; }
__device__ __forceinline__ bf16x8 ld8(const bf16_t* p) { return *reinterpret_cast<const bf16x8*>(p); }

__device__ __forceinline__ void partialSM(f32x16& p0, f32x16& p1, float& m_reg, float& mn, float& alpha) {
  constexpr float C = SCALE * 1.4426950408889634f;
  float pmax = p0[0];
#pragma unroll
  for (int r = 1; r < 16; ++r) pmax = fmaxf(pmax, p0[r]);
#pragma unroll
  for (int r = 0; r < 16; ++r) pmax = fmaxf(pmax, p1[r]);
  { auto rr = __builtin_amdgcn_permlane32_swap(__float_as_uint(pmax), __float_as_uint(pmax), false, false);
    pmax = fmaxf(__uint_as_float(rr[0]), __uint_as_float(rr[1])); }
  if (__builtin_expect(__all(pmax - m_reg <= THR / SCALE), 1)) { mn = m_reg; alpha = 1.f; }
  else { mn = fmaxf(m_reg, pmax); alpha = __builtin_amdgcn_exp2f((m_reg - mn) * C); m_reg = mn; }
  float mnC = -mn * C;
#pragma unroll
  for (int r = 0; r < 16; ++r) p0[r] = fmaf(p0[r], C, mnC);
#pragma unroll
  for (int r = 0; r < 16; ++r) p1[r] = fmaf(p1[r], C, mnC);
#pragma unroll
  for (int r = 0; r < 16; ++r) p0[r] = __builtin_amdgcn_exp2f(p0[r]);
}
__device__ __forceinline__ void finishSM(f32x16& p0, f32x16& p1, float alpha, float& l_reg, bf16x8& pa0, bf16x8& pa1, bf16x8& pa2, bf16x8& pa3) {
#pragma unroll
  for (int r = 0; r < 16; ++r) p1[r] = __builtin_amdgcn_exp2f(p1[r]);
  float ps = 0;
#pragma unroll
  for (int r = 0; r < 16; ++r) ps += p0[r];
#pragma unroll
  for (int r = 0; r < 16; ++r) ps += p1[r];
  { auto rr = __builtin_amdgcn_permlane32_swap(__float_as_uint(ps), __float_as_uint(ps), false, false);
    ps = __uint_as_float(rr[0]) + __uint_as_float(rr[1]); }
  l_reg = l_reg * alpha + ps;
#define PK4(P, BASE, OUT) do { unsigned a0 = cvtpk(P[BASE + 0], P[BASE + 1]), a1 = cvtpk(P[BASE + 2], P[BASE + 3]);   \
    unsigned b0 = cvtpk(P[BASE + 4], P[BASE + 5]), b1 = cvtpk(P[BASE + 6], P[BASE + 7]);                              \
    auto r0 = __builtin_amdgcn_permlane32_swap(a0, b0, false, false); auto r1 = __builtin_amdgcn_permlane32_swap(a1, b1, false, false); \
    u32x4 w = {r0[0], r1[0], r0[1], r1[1]}; OUT = *reinterpret_cast<bf16x8*>(&w); } while (0)
  PK4(p0, 0, pa0); PK4(p0, 8, pa1); PK4(p1, 0, pa2); PK4(p1, 8, pa3);
#undef PK4
}
__device__ __forceinline__ void qkt(f32x16& p0, f32x16& p1, const char* Ks, const bf16x8* qr, const char* qrl, int r32, int hi) {
  p0 = f32x16{}; p1 = f32x16{};
#pragma unroll
  for (int d0 = 0; d0 < 12; ++d0) { int cb = (d0 * 16 + hi * 8) * 2;
    bf16x8 b0 = *reinterpret_cast<const bf16x8*>(Ks + r32 * 400 + hi * 16 + d0 * 32);
    bf16x8 b1 = *reinterpret_cast<const bf16x8*>(Ks + r32 * 400 + hi * 16 + d0 * 32 + 32 * 400);
    const bf16x8 qf = (d0 < 8) ? qr[d0 < 8 ? d0 : 0] : *reinterpret_cast<const bf16x8*>(qrl + (d0 - 8) * 1024);
    p0 = __builtin_amdgcn_mfma_f32_32x32x16_bf16(b0, qf, p0, 0, 0, 0);
    p1 = __builtin_amdgcn_mfma_f32_32x32x16_bf16(b1, qf, p1, 0, 0, 0); }
}
__device__ __forceinline__ int v_st(int k, int c) { const int kk = (k & ~0xC) | ((k & 4) << 1) | ((k & 8) >> 1); return ((kk >> 3) * 4 + (c >> 5)) * 512 + ((kk & 7) * 32 + (c & 31)) * 2; }
__device__ __forceinline__ int v_rd_base(int lane) { return ((lane & 3) << 3) | (((lane >> 2) & 3) << 6) | (((lane >> 4) & 1) << 5) | (((lane >> 5) & 1) << 8); }
constexpr int v_rd_off(int d0, int ks, int half) { return d0 * 512 + ks * 4096 + half * 2048; }
template <int OFF> __device__ __forceinline__ s16x4 tr_read(int vb) {
  s16x4 r; asm volatile("ds_read_b64_tr_b16 %0, %1 offset:%2" : "=&v"(r) : "v"(vb), "i"(OFF) : "memory"); return r;
}
template <int D0> __device__ __forceinline__ void pv_one(f32x16& od, int vb, bf16x8 pa0, bf16x8 pa1, bf16x8 pa2, bf16x8 pa3) {
  const s16x4 l0 = tr_read<v_rd_off(D0, 0, 0)>(vb), h0 = tr_read<v_rd_off(D0, 0, 1)>(vb), l1 = tr_read<v_rd_off(D0, 1, 0)>(vb), h1 = tr_read<v_rd_off(D0, 1, 1)>(vb);
  const s16x4 l2 = tr_read<v_rd_off(D0, 2, 0)>(vb), h2 = tr_read<v_rd_off(D0, 2, 1)>(vb), l3 = tr_read<v_rd_off(D0, 3, 0)>(vb), h3 = tr_read<v_rd_off(D0, 3, 1)>(vb);
  asm volatile("s_waitcnt lgkmcnt(0)" ::: "memory"); SBAR();
#define PK(L, H) (bf16x8){L[0], L[1], L[2], L[3], H[0], H[1], H[2], H[3]}
  od = __builtin_amdgcn_mfma_f32_32x32x16_bf16(pa0, PK(l0, h0), od, 0, 0, 0);
  od = __builtin_amdgcn_mfma_f32_32x32x16_bf16(pa1, PK(l1, h1), od, 0, 0, 0);
  od = __builtin_amdgcn_mfma_f32_32x32x16_bf16(pa2, PK(l2, h2), od, 0, 0, 0);
  od = __builtin_amdgcn_mfma_f32_32x32x16_bf16(pa3, PK(l3, h3), od, 0, 0, 0);
#undef PK
}
__device__ __forceinline__ void pv_d0(f32x16* o, int vb, bf16x8 pa0, bf16x8 pa1, bf16x8 pa2, bf16x8 pa3) {
  pv_one<0>(o[0], vb, pa0, pa1, pa2, pa3); pv_one<1>(o[1], vb, pa0, pa1, pa2, pa3); pv_one<2>(o[2], vb, pa0, pa1, pa2, pa3); pv_one<3>(o[3], vb, pa0, pa1, pa2, pa3);
}
__device__ __forceinline__ float bf2f(short x) { return __uint_as_float(((unsigned)(unsigned short)x) << 16); }

__device__ __forceinline__ void attn_unit(const bf16_t* __restrict__ Qb, const bf16_t* __restrict__ Kh, const bf16_t* __restrict__ KRb, const float2* __restrict__ CSb,
                                          bf16_t* __restrict__ Ob, int seq, char* lds) {
  const int tid = threadIdx.x, wid = tid >> 6, lane = tid & 63, r32 = lane & 31, hi = lane >> 5;
  const bf16_t* Vh = Kh + 128;
  char* V_lds = lds; char* K_lds = lds + 2 * SHM_V;
  float* ws = (float*)(lds + 2 * SHM_V + 2 * SHM_K) + wid * 64; float* li_l = ws; float* al_l = ws + 32;
  float m_reg = -1e30f, l_reg = 0; f32x16 o[4] = {}; bf16x8 qr[8]; char* qrl = lds + SHM_QR + wid * 4096 + lane * 16;
  const bf16_t* Qw = Qb + (long)(wid * QBLK + r32) * LDQ + hi * 8;
#pragma unroll
  for (int d0 = 0; d0 < 8; ++d0) qr[d0] = ld8(Qw + d0 * 16);
  {
    const float2* cs = CSb + (long)(wid * QBLK + r32) * 32 + hi * 8;
#pragma unroll
    for (int dd = 0; dd < 2; ++dd) {
      const bf16x8 qa = ld8(Qw + (8 + dd) * 16), qb2 = ld8(Qw + (10 + dd) * 16);
      float o1[8], o2[8];
#pragma unroll
      for (int j = 0; j < 8; ++j) { const float2 c = cs[dd * 16 + j]; const float t1 = bf2f(qa[j]), t2 = bf2f(qb2[j]);
        o1[j] = t1 * c.x - t2 * c.y; o2[j] = t1 * c.y + t2 * c.x; }
      u32x4 w1 = {cvtpk(o1[0], o1[1]), cvtpk(o1[2], o1[3]), cvtpk(o1[4], o1[5]), cvtpk(o1[6], o1[7])};
      u32x4 w2 = {cvtpk(o2[0], o2[1]), cvtpk(o2[2], o2[3]), cvtpk(o2[4], o2[5]), cvtpk(o2[6], o2[7])};
      *reinterpret_cast<u32x4*>(qrl + dd * 1024) = w1; *reinterpret_cast<u32x4*>(qrl + (2 + dd) * 1024) = w2;
    }
  }
  const int sr = tid >> 4, sc = (tid & 15) * 8, vst0 = v_st(sr, sc);
  const int rr_ = tid >> 3, rc_ = (tid & 7) * 8;
  const int vb0 = (int)(uintptr_t)V_lds + v_rd_base(lane);
  struct { bf16x8 vs0, vs1, ks0, ks1, kr; } sr_[SDEPTH];
  const unsigned toff = (unsigned)(sr * LDK + sc), troff = (unsigned)(rr_ * LDKR + rc_);
#define SLOAD(i, k0) do { const bf16_t* kb_ = Kh + (size_t)(k0) * LDK; const bf16_t* rb_ = KRb + (size_t)(k0) * LDKR; \
    sr_[i].vs0 = ld8(kb_ + 128 + toff); sr_[i].vs1 = ld8(kb_ + 32 * LDK + 128 + toff); \
    sr_[i].ks0 = ld8(kb_ + toff); sr_[i].ks1 = ld8(kb_ + 32 * LDK + toff); \
    sr_[i].kr = ld8(rb_ + troff); } while (0)
  const int kst0 = KSWZ(sr, sc * 2), krst = KSWZ(rr_, 256 + rc_ * 2);
#define SWRITE(b, i) do { *(bf16x8*)(V_lds + (b) * SHM_V + vst0) = sr_[i].vs0;          \
    *(bf16x8*)(V_lds + (b) * SHM_V + 8192 + vst0) = sr_[i].vs1;               \
    *(bf16x8*)(K_lds + (b) * SHM_K + kst0) = sr_[i].ks0;                       \
    *(bf16x8*)(K_lds + (b) * SHM_K + 32 * 400 + kst0) = sr_[i].ks1;                  \
    *(bf16x8*)(K_lds + (b) * SHM_K + krst) = sr_[i].kr; } while (0)
#define SWAIT() do { if constexpr (SDEPTH == 2) asm volatile("s_waitcnt vmcnt(5)" ::: "memory"); else asm volatile("s_waitcnt vmcnt(0)" ::: "memory"); } while (0)
#define RESC(a) do { if (__any((a) < 1.f)) { if (hi == 0) al_l[r32] = (a); asm volatile("s_waitcnt lgkmcnt(0)" ::: "memory"); \
    _Pragma("unroll") for (int d = 0; d < 4; ++d) _Pragma("unroll") for (int r = 0; r < 16; ++r) o[d][r] *= al_l[crow(r, hi)]; } } while (0)
  f32x16 pA0, pA1, pB0, pB1; float mnA, mnB, alA, alB; bf16x8 pa0, pa1, pa2, pa3; const int NT = seq / KVBLK;
  constexpr int SE = 0, SO = SDEPTH - 1;
  SLOAD(SE, 0); asm volatile("s_waitcnt vmcnt(0)" ::: "memory"); SWRITE(0, SE); __syncthreads();
  qkt(pA0, pA1, K_lds, qr, qrl, r32, hi); partialSM(pA0, pA1, m_reg, mnA, alA);
  SLOAD(SO, KVBLK); if constexpr (SDEPTH == 2) { if (2 < NT) SLOAD(SE, 2 * KVBLK); }
  SWAIT(); SWRITE(1, SO); __syncthreads();
  for (int j = 1; j + 1 < NT; j += 2) {
    SBAR(); qkt(pB0, pB1, K_lds + SHM_K, qr, qrl, r32, hi);
    finishSM(pA0, pA1, alA, l_reg, pa0, pa1, pa2, pa3); SBAR();
    SLOAD(SO, (j + SDEPTH) * KVBLK); SBAR();
    pv_d0(o, vb0, pa0, pa1, pa2, pa3); partialSM(pB0, pB1, m_reg, mnB, alB);
    __syncthreads(); SWAIT(); SWRITE(0, SE);
    RESC(alB); __syncthreads();
    SBAR(); qkt(pA0, pA1, K_lds, qr, qrl, r32, hi);
    finishSM(pB0, pB1, alB, l_reg, pa0, pa1, pa2, pa3); SBAR();
    if (SDEPTH == 1 || j + 3 < NT) SLOAD(SE, (j + 1 + SDEPTH) * KVBLK); SBAR();
    pv_d0(o, vb0 + (int)SHM_V, pa0, pa1, pa2, pa3); partialSM(pA0, pA1, m_reg, mnA, alA);
    __syncthreads(); SWAIT(); SWRITE(1, SO);
    RESC(alA); __syncthreads();
  }
  SBAR(); qkt(pB0, pB1, K_lds + SHM_K, qr, qrl, r32, hi);
  finishSM(pA0, pA1, alA, l_reg, pa0, pa1, pa2, pa3); SBAR();
  pv_d0(o, vb0, pa0, pa1, pa2, pa3); partialSM(pB0, pB1, m_reg, mnB, alB);
  __syncthreads(); RESC(alB);
  finishSM(pB0, pB1, alB, l_reg, pa0, pa1, pa2, pa3); SBAR();
  pv_d0(o, vb0 + (int)SHM_V, pa0, pa1, pa2, pa3);
  if (hi == 0) li_l[r32] = l_reg; asm volatile("s_waitcnt lgkmcnt(0)" ::: "memory");
  float rli[16];
#pragma unroll
  for (int r = 0; r < 16; ++r) rli[r] = __builtin_amdgcn_rcpf(li_l[crow(r, hi)]);
  bf16_t* Ow = Ob + (long)(wid * QBLK) * LDO;
#pragma unroll
  for (int r = 0; r < 16; ++r) { int orow = crow(r, hi);
#pragma unroll
    for (int d0 = 0; d0 < 4; ++d0) { const unsigned w = cvtpk(o[d0][r] * rli[r], 0.f); Ow[(long)orow * LDO + d0 * 32 + r32] = (bf16_t)(w & 0xffffu); } }
  __syncthreads();
#undef SLOAD
#undef SWRITE
#undef SWAIT
#undef RESC
}
#undef KSWZ
#undef SBAR
}
namespace gla {
typedef unsigned short bf16_t;
typedef short bf16x8 __attribute__((ext_vector_type(8)));
typedef float f32x4 __attribute__((ext_vector_type(4)));
typedef unsigned u32x4 __attribute__((ext_vector_type(4)));
typedef unsigned u32x2 __attribute__((ext_vector_type(2)));
constexpr int PQ = 272, PT = 144;
constexpr int L_QD = 0, L_KI = L_QD + 64 * PQ, L_SB = L_KI + 64 * PQ, L_KET = L_SB + 128 * PQ, L_VT = L_KET + 128 * PT, L_AT = L_VT + 128 * PT, L_DEC = L_AT + 64 * PT, L_END = L_DEC + 512;
constexpr int PROJ_LD = 5120;
typedef float f32x2_t __attribute__((ext_vector_type(2))); typedef __bf16 bf16x2_t __attribute__((ext_vector_type(2)));
__device__ __forceinline__ unsigned cvtpk(float lo, float hi) { f32x2_t v = {lo, hi}; bf16x2_t b = __builtin_convertvector(v, bf16x2_t); return __builtin_bit_cast(unsigned, b); }
__device__ __forceinline__ float bflo(unsigned w) { return __uint_as_float(w << 16); }
__device__ __forceinline__ float bfhi(unsigned w) { return __uint_as_float(w & 0xffff0000u); }
template <int CTRL, int ROWM> __device__ __forceinline__ float dpp0(float v) { return __int_as_float(__builtin_amdgcn_update_dpp(0, __float_as_int(v), CTRL, ROWM, 0xf, false)); }
template <int CTRL, int ROWM> __device__ __forceinline__ float dpp1(float v) { return __int_as_float(__builtin_amdgcn_update_dpp(0x3f800000, __float_as_int(v), CTRL, ROWM, 0xf, false)); }
#define GBAR() asm volatile("s_waitcnt lgkmcnt(0)\n\ts_barrier" ::: "memory")
#define MFMA16(a, b, c) __builtin_amdgcn_mfma_f32_16x16x32_bf16((a), (b), (c), 0, 0, 0)
#define LDSV(off) (*(const bf16x8*)(lds + (off)))

struct ChunkRegs { u32x4 q[2], f[2], v[2]; };
__device__ __forceinline__ void load_chunk(ChunkRegs& c, const bf16_t* __restrict__ PROJ, int b, int cc, int tl, size_t colq, size_t colf, size_t colv) {
  const bf16_t* rp = PROJ + ((size_t)b * 4096 + cc * 64 + tl) * PROJ_LD;
  c.q[0] = *(const u32x4*)(rp + colq); c.q[1] = *(const u32x4*)(rp + colq + 8); c.f[0] = *(const u32x4*)(rp + colf); c.f[1] = *(const u32x4*)(rp + colf + 8);
  c.v[0] = *(const u32x4*)(rp + colv); c.v[1] = *(const u32x4*)(rp + colv + 8);
}
__device__ __forceinline__ void scan_step(const ChunkRegs& c, f32x4 (&sacc)[8], const float (&lbk)[16], bf16_t* __restrict__ Odir, char* lds,
                                          int b, int h, int dir, int cc, int wid, int lane, int fr, int fq, int kbase) {
    float P[16], k0[16];
#pragma unroll
    for (int kk = 0; kk < 16; ++kk) { const unsigned w = c.f[kk >> 3][(kk & 7) >> 1]; const float x = (kk & 1) ? bfhi(w) : bflo(w);
      const float e = __expf(-x), sg = __builtin_amdgcn_rcpf(1.f + e); const float oml = 1.f - lbk[kk];
      P[kk] = lbk[kk] + oml * sg; k0[kk] = oml * (e * sg); }
#pragma unroll
    for (int kk = 0; kk < 16; ++kk) { float v = P[kk];
      v *= dpp1<0x111, 0xf>(v); v *= dpp1<0x112, 0xf>(v); v *= dpp1<0x114, 0xf>(v); v *= dpp1<0x118, 0xf>(v);
      v *= dpp1<0x142, 0xa>(v); v *= dpp1<0x143, 0xc>(v);
      P[kk] = v; }
    float qd[16], ki[16];
#pragma unroll
    for (int kk = 0; kk < 16; ++kk) { const float Pl = __int_as_float(__builtin_amdgcn_readlane(__float_as_int(P[kk]), 63));
      const unsigned wq = c.q[kk >> 3][(kk & 7) >> 1]; const float q = (kk & 1) ? bfhi(wq) : bflo(wq);
      const unsigned wv = c.v[kk >> 3][(kk & 7) >> 1]; const float v = (kk & 1) ? bfhi(wv) : bflo(wv);
      qd[kk] = q * 0.08838834764831845f * P[kk]; ki[kk] = k0[kk] * __builtin_amdgcn_rcpf(P[kk]);
      const float ke = ki[kk] * Pl;
      *(bf16_t*)(lds + L_KET + (kbase + kk) * PT + lane * 2) = (bf16_t)(cvtpk(ke, 0.f) & 0xffffu);
      *(bf16_t*)(lds + L_VT + (kbase + kk) * PT + lane * 2) = (bf16_t)(cvtpk(v, 0.f) & 0xffffu); }
    if (lane == 63) {
#pragma unroll
      for (int g4 = 0; g4 < 4; ++g4) *(f32x4*)(lds + L_DEC + (kbase + 4 * g4) * 4) = (f32x4){P[4 * g4], P[4 * g4 + 1], P[4 * g4 + 2], P[4 * g4 + 3]}; }
#pragma unroll
    for (int g8 = 0; g8 < 2; ++g8) {
      u32x4 w; w.x = cvtpk(qd[8 * g8 + 0], qd[8 * g8 + 1]); w.y = cvtpk(qd[8 * g8 + 2], qd[8 * g8 + 3]); w.z = cvtpk(qd[8 * g8 + 4], qd[8 * g8 + 5]); w.w = cvtpk(qd[8 * g8 + 6], qd[8 * g8 + 7]);
      *(u32x4*)(lds + L_QD + lane * PQ + (kbase + 8 * g8) * 2) = w;
      u32x4 z; z.x = cvtpk(ki[8 * g8 + 0], ki[8 * g8 + 1]); z.y = cvtpk(ki[8 * g8 + 2], ki[8 * g8 + 3]); z.z = cvtpk(ki[8 * g8 + 4], ki[8 * g8 + 5]); z.w = cvtpk(ki[8 * g8 + 6], ki[8 * g8 + 7]);
      *(u32x4*)(lds + L_KI + lane * PQ + (kbase + 8 * g8) * 2) = z;
    }
    GBAR();
#pragma unroll
    for (int q2 = 0; q2 < 2; ++q2) { const int id = 2 * wid + q2, jt = id >> 2, it = id & 3;
      f32x4 cacc = (f32x4){0.f, 0.f, 0.f, 0.f};
      if (jt <= it) {
#pragma unroll
        for (int ks = 0; ks < 4; ++ks) { const bf16x8 a = LDSV(L_KI + (16 * jt + fr) * PQ + (32 * ks + 8 * fq) * 2); const bf16x8 bq = LDSV(L_QD + (16 * it + fr) * PQ + (32 * ks + 8 * fq) * 2); cacc = MFMA16(a, bq, cacc); }
      }
      const int i = 16 * it + fr, j0 = 16 * jt + 4 * fq;
      const float c0 = (j0 + 0 <= i) ? cacc[0] : 0.f, c1 = (j0 + 1 <= i) ? cacc[1] : 0.f, c2 = (j0 + 2 <= i) ? cacc[2] : 0.f, c3 = (j0 + 3 <= i) ? cacc[3] : 0.f;
      u32x2 w; w.x = cvtpk(c0, c1); w.y = cvtpk(c2, c3);
      *(u32x2*)(lds + L_AT + i * PT + j0 * 2) = w; }
    { const bf16x8 a0 = LDSV(L_KET + (kbase + fr) * PT + (8 * fq) * 2), a1 = LDSV(L_KET + (kbase + fr) * PT + (32 + 8 * fq) * 2);
      const f32x4 d4 = *(const f32x4*)(lds + L_DEC + (kbase + 4 * fq) * 4);
#pragma unroll
      for (int n = 0; n < 8; ++n) { const bf16x8 b0 = LDSV(L_VT + (16 * n + fr) * PT + (8 * fq) * 2), b1 = LDSV(L_VT + (16 * n + fr) * PT + (32 + 8 * fq) * 2);
        f32x4 t = sacc[n] * d4; t = MFMA16(a0, b0, t); sacc[n] = MFMA16(a1, b1, t); } }
    GBAR();
    { bf16x8 av[2], as[4];
#pragma unroll
      for (int ks = 0; ks < 2; ++ks) av[ks] = LDSV(L_VT + (kbase + fr) * PT + (32 * ks + 8 * fq) * 2);
#pragma unroll
      for (int ks = 0; ks < 4; ++ks) as[ks] = LDSV(L_SB + (kbase + fr) * PQ + (32 * ks + 8 * fq) * 2);
#pragma unroll
      for (int tt = 0; tt < 4; ++tt) { f32x4 cacc = (f32x4){0.f, 0.f, 0.f, 0.f};
#pragma unroll
        for (int ks = 0; ks < 2; ++ks) cacc = MFMA16(av[ks], LDSV(L_AT + (16 * tt + fr) * PT + (32 * ks + 8 * fq) * 2), cacc);
#pragma unroll
        for (int ks = 0; ks < 4; ++ks) cacc = MFMA16(as[ks], LDSV(L_QD + (16 * tt + fr) * PQ + (32 * ks + 8 * fq) * 2), cacc);
        const int t = 16 * tt + fr, tg = dir ? 63 - t : t;
        u32x2 w; w.x = cvtpk(cacc[0], cacc[1]); w.y = cvtpk(cacc[2], cacc[3]);
        *(u32x2*)(Odir + ((size_t)b * 4096 + cc * 64 + tg) * 1024 + h * 128 + kbase + 4 * fq) = w; } }
    GBAR();
#pragma unroll
    for (int n = 0; n < 8; ++n) { u32x2 w; w.x = cvtpk(sacc[n][0], sacc[n][1]); w.y = cvtpk(sacc[n][2], sacc[n][3]);
      *(u32x2*)(lds + L_SB + (16 * n + fr) * PQ + (kbase + 4 * fq) * 2) = w; }
}

__device__ __forceinline__ void scan_chain(const bf16_t* __restrict__ PROJ, const float* __restrict__ lbv, bf16_t* __restrict__ OF, bf16_t* __restrict__ OB, int chain, char* lds) {
  const int tid = threadIdx.x, wid = __builtin_amdgcn_readfirstlane(tid >> 6), lane = tid & 63, fr = lane & 15, fq = lane >> 4;
  const int dir = chain & 1, h = (chain >> 1) & 7, b = chain >> 4;
  bf16_t* Odir = dir ? OB : OF;
  const int kbase = 16 * wid;
  float lbk[16];
#pragma unroll
  for (int kk = 0; kk < 16; ++kk) lbk[kk] = lbv[h * 128 + kbase + kk];
  for (int i = tid; i < (128 * PQ) / 16; i += 512) *(u32x4*)(lds + L_SB + i * 16) = (u32x4){0u, 0u, 0u, 0u};
  f32x4 sacc[8];
#pragma unroll
  for (int n = 0; n < 8; ++n) sacc[n] = (f32x4){0.f, 0.f, 0.f, 0.f};
  const int tl = dir ? 63 - lane : lane;
  const size_t colq = (size_t)h * 128 + kbase, colf = 1024 + (size_t)dir * 1024 + colq, colv = 3072 + colq;
  ChunkRegs A, B;
  load_chunk(A, PROJ, b, dir ? 63 : 0, tl, colq, colf, colv);
  __syncthreads();
  for (int s = 0; s < 64; s += 2) {
    { const int cn = dir ? 62 - s : s + 1; load_chunk(B, PROJ, b, cn, tl, colq, colf, colv); }
    scan_step(A, sacc, lbk, Odir, lds, b, h, dir, dir ? 63 - s : s, wid, lane, fr, fq, kbase);
    if (s + 2 < 64) { const int cn = dir ? 61 - s : s + 2; load_chunk(A, PROJ, b, cn, tl, colq, colf, colv); }
    scan_step(B, sacc, lbk, Odir, lds, b, h, dir, dir ? 62 - s : s + 1, wid, lane, fr, fq, kbase);
  }
  __syncthreads();
}
#undef GBAR
#undef MFMA16
#undef LDSV
}
#define LAS __attribute__((address_space(3)))
#define XB_TMO      128
#define XB_XCNT(j)  (256  + 64 * (j))
#define XB_XSUB(j)  (1280 + 64 * (j))
#define XB_XGEN(j)  (2304 + 64 * (j))
#define XB_TOP      3328
#define XB_TOPGEN   3392
#define XCD_BAR_WORDS 3456
#define XB_SPIN_CAP (1u << 18)

__device__ __forceinline__ unsigned xb_ld(unsigned* p)              { return __hip_atomic_load(p, __ATOMIC_RELAXED, __HIP_MEMORY_SCOPE_AGENT); }
__device__ __forceinline__ unsigned xb_add(unsigned* p, unsigned v) { return __hip_atomic_fetch_add(p, v, __ATOMIC_RELAXED, __HIP_MEMORY_SCOPE_AGENT); }
__device__ __forceinline__ unsigned xb_xcc_id() { return (unsigned)__builtin_amdgcn_s_getreg((3 << 11) | 20) & 0xFu; }
#define XB_SPIN(cond, bar) do { unsigned _sp = 0; while (cond) { __builtin_amdgcn_s_sleep(1); \
    if ((++_sp & 255u) == 0u) { if (xb_ld(&(bar)[XB_TMO])) break; if (_sp > XB_SPIN_CAP) { atomicAdd(&(bar)[XB_TMO], 1u); break; } } } } while (0)

struct XcdBarrier {
    unsigned* bar; unsigned x;
    volatile LAS unsigned* st;
};

__device__ __forceinline__ XcdBarrier xcd_barrier_post(unsigned* bar, volatile LAS unsigned* st) {
    XcdBarrier b; b.bar = bar; b.x = xb_xcc_id(); b.st = st;
    if (threadIdx.x == 0) (void)xb_add(&bar[XB_XCNT(b.x)], 1u);
    return b;
}
__device__ __forceinline__ void xcd_barrier_complete(unsigned* bar, unsigned x, unsigned& nloc, unsigned& nx) {
    const unsigned G = gridDim.x * gridDim.y * gridDim.z;
    unsigned sum, cnt, mine, sp = 0u;
    for (;;) {
        sum = 0u; cnt = 0u; mine = 0u;
#pragma unroll
        for (unsigned j = 0; j < 16; ++j) { const unsigned c = xb_ld(&bar[XB_XCNT(j)]); sum += c; cnt += (c > 0u) ? 1u : 0u; mine = (j == x) ? c : mine; }
        if (sum == G) break;
        __builtin_amdgcn_s_sleep(1);
        if ((++sp & 255u) == 0u) { if (xb_ld(&bar[XB_TMO])) break; if (sp > XB_SPIN_CAP) { atomicAdd(&bar[XB_TMO], 1u); break; } }
    }
    nloc = mine > 0u ? mine : 1u; nx = cnt > 0u ? cnt : 1u;
}

__device__ __forceinline__ void xcd_barrier(const XcdBarrier& b) {
    asm volatile("s_waitcnt vmcnt(0)" ::: "memory");
    __syncthreads();
    if (threadIdx.x == 0) {
        unsigned* bar = b.bar;
        __builtin_amdgcn_s_waitcnt(0);
        unsigned nloc = b.st[0], nx = b.st[1];
        if (nloc == 0u) { xcd_barrier_complete(bar, b.x, nloc, nx); b.st[0] = nloc; b.st[1] = nx; }
        const unsigned old = xb_add(&bar[XB_XSUB(b.x)], 1u);
        const unsigned gen = old / nloc;
        if (old + 1u == (gen + 1u) * nloc) {
            __builtin_amdgcn_fence(__ATOMIC_RELEASE, "agent");
            asm volatile("s_waitcnt vmcnt(0)" ::: "memory");
            const unsigned og = xb_add(&bar[XB_TOP], 1u);
            const unsigned tg = og / nx;
            if (og + 1u == (tg + 1u) * nx) xb_add(&bar[XB_TOPGEN], 1u);
            else XB_SPIN(xb_ld(&bar[XB_TOPGEN]) == tg, bar);
            __builtin_amdgcn_fence(__ATOMIC_ACQUIRE, "agent");
            xb_add(&bar[XB_XGEN(b.x)], 1u);
            asm volatile("s_waitcnt vmcnt(0)" ::: "memory");
        } else {
            XB_SPIN(xb_ld(&bar[XB_XGEN(b.x)]) == gen, bar);
            __builtin_amdgcn_fence(__ATOMIC_ACQUIRE, "agent");
            asm volatile("s_waitcnt vmcnt(0)" ::: "memory");
        }
    }
    __syncthreads();
}
typedef unsigned short bf16_t;
typedef float f32x4 __attribute__((ext_vector_type(4)));
typedef unsigned u32x4 __attribute__((ext_vector_type(4)));
typedef unsigned u32x2 __attribute__((ext_vector_type(2)));
constexpr int NT_ = 65536, DM = 1024, SEQ = 4096, NB = 16, DFF = 4096;
constexpr float EPS = 1e-6f;
constexpr size_t MiB = 1u << 20;
constexpr size_t W_HGIN = 0, W_HGOUT = W_HGIN + 10 * MiB, W_UP = W_HGOUT + 2 * MiB  , W_DN = W_UP + 16 * MiB  , W_PP = W_DN + 16 * MiB  ,
                 W_PG = W_PP + 1 * MiB  , W_MLAIN = W_PG + 4 * MiB  , W_UQ = W_MLAIN + 1536 * 1024  , W_UKV = W_UQ + 2304 * 1024  , W_O = W_UKV + 2 * MiB  , W_END = W_O + 4 * MiB;
static_assert(W_END <= 59 * MiB, "weights");
constexpr size_t WS_PART = 59 * MiB, WS_LB = 63 * MiB, WS_P16 = 64 * MiB, WS_BIG0 = 96 * MiB, WS_HID = 224 * MiB, WS_A = 736 * MiB, WS_B = 864 * MiB, WS_CS = 992 * MiB;
constexpr size_t WS_CQ = 96 * MiB, WS_CKV = 144 * MiB, WS_KR = 176 * MiB, WS_QH = 192 * MiB, WS_KVH = 384 * MiB, WS_M3 = 384 * MiB;
constexpr size_t WS_NEED = 1008 * MiB;
constexpr int LDS_BYTES = 135168;
constexpr int XB_LDS_OFF = 131072 + 256;
constexpr size_t WS_CTL = 63 * MiB + 512 * 1024, CTL_BYTES = 16384;

typedef float f32x2_t __attribute__((ext_vector_type(2))); typedef __bf16 bf16x2_t __attribute__((ext_vector_type(2)));
__device__ __forceinline__ unsigned pk2(float lo, float hi) { f32x2_t v = {lo, hi}; bf16x2_t b = __builtin_convertvector(v, bf16x2_t); return __builtin_bit_cast(unsigned, b); }
__device__ __forceinline__ float wave_sum(float v) {
#pragma unroll
  for (int o = 1; o < 64; o <<= 1) v += __shfl_xor(v, o);
  return v;
}
__device__ __forceinline__ void transpose_item(const float* __restrict__ W, int K, int N, bf16_t* __restrict__ WT, float* scr, int item, int lane) {
  const int nblk = N / 32, kb = item / nblk, nb = item % nblk, k0 = 64 * kb, n0 = 32 * nb;
  float wv[32];
#pragma unroll
  for (int i = 0; i < 32; ++i) { const int kk = 2 * i + (lane >> 5); wv[i] = W[(size_t)(k0 + kk) * N + n0 + (lane & 31)]; }
#pragma unroll
  for (int i = 0; i < 32; ++i) { const int kk = 2 * i + (lane >> 5); scr[kk * 33 + (lane & 31)] = wv[i]; }
  asm volatile("s_waitcnt lgkmcnt(0)" ::: "memory");
  const int c = lane & 7;
#pragma unroll
  for (int j = 0; j < 4; ++j) { const int n = (lane >> 3) + 8 * j; const float* s = scr + (8 * c) * 33 + n;
    u32x4 o; o.x = pk2(s[0 * 33], s[1 * 33]); o.y = pk2(s[2 * 33], s[3 * 33]); o.z = pk2(s[4 * 33], s[5 * 33]); o.w = pk2(s[6 * 33], s[7 * 33]);
    *(u32x4*)(WT + (size_t)(n0 + n) * K + k0 + 8 * c) = o; }
  asm volatile("s_waitcnt lgkmcnt(0)" ::: "memory");
}

struct Args { const float* in[22]; float* out; unsigned char* ws; int ph_lo, ph_hi; };

struct RowOp { const bf16_t* hin16; bf16_t* hout16; const float* hin; const bf16_t* m; const float* part; const float* gpost; float* hout; bf16_t* aout; const float* gnext; const float* pin; bf16_t* p16; };
constexpr int RB = 4;
__device__ __forceinline__ void row_phase(const RowOp& r, int gw, int ngw, int lane) {
  for (int row0 = gw * RB; row0 < NT_; row0 += ngw * RB) {
    f32x4 v[RB][4]; u32x2 mm[RB][4]; float pp[RB];
    if (r.hin16) {
#pragma unroll
      for (int b = 0; b < RB; ++b) { const bf16_t* hr = r.hin16 + (size_t)(row0 + b) * DM + 4 * lane;
#pragma unroll
        for (int j = 0; j < 4; ++j) { const u32x2 hh = *(const u32x2*)(hr + 256 * j); v[b][j] = (f32x4){__uint_as_float(hh.x << 16), __uint_as_float(hh.x & 0xffff0000u), __uint_as_float(hh.y << 16), __uint_as_float(hh.y & 0xffff0000u)}; } }
    } else {
#pragma unroll
      for (int b = 0; b < RB; ++b) { const float* hr = r.hin + (size_t)(row0 + b) * DM + 4 * lane;
#pragma unroll
        for (int j = 0; j < 4; ++j) v[b][j] = *(const f32x4*)(hr + 256 * j); }
    }
    if (r.m) {
#pragma unroll
      for (int b = 0; b < RB; ++b) { pp[b] = r.part[(size_t)(row0 + b) * 16 + (lane & 15)]; const bf16_t* mr = r.m + (size_t)(row0 + b) * DM + 4 * lane;
#pragma unroll
        for (int j = 0; j < 4; ++j) mm[b][j] = *(const u32x2*)(mr + 256 * j); }
      f32x4 g[4];
#pragma unroll
      for (int j = 0; j < 4; ++j) g[j] = *(const f32x4*)(r.gpost + 4 * lane + 256 * j);
#pragma unroll
      for (int b = 0; b < RB; ++b) { float p_ = pp[b]; p_ += __shfl_xor(p_, 1); p_ += __shfl_xor(p_, 2); p_ += __shfl_xor(p_, 4); p_ += __shfl_xor(p_, 8);
        const float rs = rsqrtf(p_ * (1.f / DM) + EPS);
#pragma unroll
        for (int j = 0; j < 4; ++j) { const u32x2 m2 = mm[b][j];
          v[b][j][0] += __uint_as_float(m2.x << 16) * rs * g[j][0]; v[b][j][1] += __uint_as_float(m2.x & 0xffff0000u) * rs * g[j][1];
          v[b][j][2] += __uint_as_float(m2.y << 16) * rs * g[j][2]; v[b][j][3] += __uint_as_float(m2.y & 0xffff0000u) * rs * g[j][3]; } }
    }
    if (r.hout) {
#pragma unroll
      for (int b = 0; b < RB; ++b) { float* ho = r.hout + (size_t)(row0 + b) * DM + 4 * lane;
#pragma unroll
        for (int j = 0; j < 4; ++j) *(f32x4*)(ho + 256 * j) = v[b][j]; } }
    if (r.hout16) {
#pragma unroll
      for (int b = 0; b < RB; ++b) { bf16_t* ho = r.hout16 + (size_t)(row0 + b) * DM + 4 * lane;
#pragma unroll
        for (int j = 0; j < 4; ++j) { u32x2 w; w.x = pk2(v[b][j][0], v[b][j][1]); w.y = pk2(v[b][j][2], v[b][j][3]); *(u32x2*)(ho + 256 * j) = w; } } }
    if (r.aout) {
      if (r.gnext) {
        f32x4 g[4];
#pragma unroll
        for (int j = 0; j < 4; ++j) g[j] = *(const f32x4*)(r.gnext + 4 * lane + 256 * j);
        float ss[RB];
#pragma unroll
        for (int b = 0; b < RB; ++b) { ss[b] = 0.f;
#pragma unroll
          for (int j = 0; j < 4; ++j) ss[b] += (v[b][j][0] * v[b][j][0] + v[b][j][1] * v[b][j][1]) + (v[b][j][2] * v[b][j][2] + v[b][j][3] * v[b][j][3]); }
#pragma unroll
        for (int o = 1; o < 64; o <<= 1) {
#pragma unroll
          for (int b = 0; b < RB; ++b) ss[b] += __shfl_xor(ss[b], o); }
#pragma unroll
        for (int b = 0; b < RB; ++b) { const float rs2 = rsqrtf(ss[b] * (1.f / DM) + EPS); bf16_t* ao = r.aout + (size_t)(row0 + b) * DM + 4 * lane;
#pragma unroll
          for (int j = 0; j < 4; ++j) { u32x2 w; w.x = pk2(v[b][j][0] * rs2 * g[j][0], v[b][j][1] * rs2 * g[j][1]); w.y = pk2(v[b][j][2] * rs2 * g[j][2], v[b][j][3] * rs2 * g[j][3]); *(u32x2*)(ao + 256 * j) = w; } }
      } else {
#pragma unroll
        for (int b = 0; b < RB; ++b) { bf16_t* ao = r.aout + (size_t)(row0 + b) * DM + 4 * lane;
#pragma unroll
          for (int j = 0; j < 4; ++j) { u32x2 w; w.x = pk2(v[b][j][0], v[b][j][1]); w.y = pk2(v[b][j][2], v[b][j][3]); *(u32x2*)(ao + 256 * j) = w; } }
      }
    }
    if (r.pin) {
#pragma unroll
      for (int b = 0; b < RB; ++b) { const f32x4 pv = *(const f32x4*)(r.pin + (size_t)(row0 + b) * 256 + 4 * lane); u32x2 w; w.x = pk2(pv[0], pv[1]); w.y = pk2(pv[2], pv[3]); *(u32x2*)(r.p16 + (size_t)(row0 + b) * 256 + 4 * lane) = w; } }
  }
}

__device__ __forceinline__ float bf_lo(unsigned w) { return __uint_as_float(w << 16); }
__device__ __forceinline__ float bf_hi(unsigned w) { return __uint_as_float(w & 0xffff0000u); }

__device__ __forceinline__ void comb_phase(bf16_t* OF, const bf16_t* OB, const bf16_t* PROJ, const float* onorm, int gw, int ngw, int lane) {
  constexpr int CB = 2;
  float on[16];
#pragma unroll
  for (int i = 0; i < 16; ++i) on[i] = onorm[16 * lane + i];
  for (int row0 = gw * CB; row0 < NT_; row0 += ngw * CB) {
    u32x4 a[CB][2], bb[CB][2], gg[CB][2];
#pragma unroll
    for (int b = 0; b < CB; ++b) { const bf16_t* of = OF + (size_t)(row0 + b) * DM + 16 * lane; const bf16_t* ob = OB + (size_t)(row0 + b) * DM + 16 * lane; const bf16_t* gt = PROJ + (size_t)(row0 + b) * 5120 + 4096 + 16 * lane;
#pragma unroll
      for (int q = 0; q < 2; ++q) { a[b][q] = *(const u32x4*)(of + 8 * q); bb[b][q] = *(const u32x4*)(ob + 8 * q); gg[b][q] = *(const u32x4*)(gt + 8 * q); } }
#pragma unroll
    for (int b = 0; b < CB; ++b) {
      float s[16], g[16];
#pragma unroll
      for (int q = 0; q < 2; ++q)
#pragma unroll
        for (int i = 0; i < 4; ++i) { s[8 * q + 2 * i] = bf_lo(a[b][q][i]) + bf_lo(bb[b][q][i]); s[8 * q + 2 * i + 1] = bf_hi(a[b][q][i]) + bf_hi(bb[b][q][i]); g[8 * q + 2 * i] = bf_lo(gg[b][q][i]); g[8 * q + 2 * i + 1] = bf_hi(gg[b][q][i]); }
      float ss = 0.f;
#pragma unroll
      for (int i = 0; i < 16; ++i) ss += s[i] * s[i];
      ss += __shfl_xor(ss, 1); ss += __shfl_xor(ss, 2); ss += __shfl_xor(ss, 4);
      const float rs = rsqrtf(ss * (1.f / 128.f) + EPS);
      float o[16];
#pragma unroll
      for (int i = 0; i < 16; ++i) { const float gv = g[i]; o[i] = s[i] * rs * on[i] * (gv * __builtin_amdgcn_rcpf(1.f + __expf(-gv))); }
      bf16_t* of = OF + (size_t)(row0 + b) * DM + 16 * lane;
#pragma unroll
      for (int q = 0; q < 2; ++q) { u32x4 w; w.x = pk2(o[8 * q], o[8 * q + 1]); w.y = pk2(o[8 * q + 2], o[8 * q + 3]); w.z = pk2(o[8 * q + 4], o[8 * q + 5]); w.w = pk2(o[8 * q + 6], o[8 * q + 7]); *(u32x4*)(of + 8 * q) = w; }
    }
  }
}

__device__ __forceinline__ void rn_phase(const bf16_t* PRJ, const float* qn, const float* kvn, const float2* CS, bf16_t* CQ, bf16_t* CKV, bf16_t* KR, int gw, int ngw, int lane) {
  constexpr int NB = 4;
  float gq[6], gk[4];
#pragma unroll
  for (int j = 0; j < 3; ++j) { gq[2 * j] = qn[2 * lane + 128 * j]; gq[2 * j + 1] = qn[2 * lane + 128 * j + 1]; }
#pragma unroll
  for (int j = 0; j < 2; ++j) { gk[2 * j] = kvn[2 * lane + 128 * j]; gk[2 * j + 1] = kvn[2 * lane + 128 * j + 1]; }
  for (int row0 = gw * NB; row0 < NT_; row0 += ngw * NB) {
    unsigned wq[NB][3], wk[NB][2], wr[NB]; f32x4 cs[NB];
#pragma unroll
    for (int b = 0; b < NB; ++b) { const unsigned* pr = (const unsigned*)(PRJ + (size_t)(row0 + b) * 768);
#pragma unroll
      for (int j = 0; j < 3; ++j) wq[b][j] = pr[lane + 64 * j];
#pragma unroll
      for (int j = 0; j < 2; ++j) wk[b][j] = pr[192 + lane + 64 * j];
      wr[b] = pr[320 + (lane & 31)];
      cs[b] = *(const f32x4*)(CS + (size_t)(row0 + b) * 32 + 2 * (lane & 15)); }
#pragma unroll
    for (int b = 0; b < NB; ++b) {
      float q[6], c[4]; float sq = 0.f, sc = 0.f;
#pragma unroll
      for (int j = 0; j < 3; ++j) { q[2 * j] = bf_lo(wq[b][j]); q[2 * j + 1] = bf_hi(wq[b][j]); sq += q[2 * j] * q[2 * j] + q[2 * j + 1] * q[2 * j + 1]; }
#pragma unroll
      for (int j = 0; j < 2; ++j) { c[2 * j] = bf_lo(wk[b][j]); c[2 * j + 1] = bf_hi(wk[b][j]); sc += c[2 * j] * c[2 * j] + c[2 * j + 1] * c[2 * j + 1]; }
      const float rq = rsqrtf(wave_sum(sq) * (1.f / 384.f) + EPS), rc = rsqrtf(wave_sum(sc) * (1.f / 256.f) + EPS);
      unsigned* oq = (unsigned*)(CQ + (size_t)(row0 + b) * 384); unsigned* ok = (unsigned*)(CKV + (size_t)(row0 + b) * 256);
#pragma unroll
      for (int j = 0; j < 3; ++j) oq[lane + 64 * j] = pk2(q[2 * j] * rq * gq[2 * j], q[2 * j + 1] * rq * gq[2 * j + 1]);
#pragma unroll
      for (int j = 0; j < 2; ++j) ok[lane + 64 * j] = pk2(c[2 * j] * rc * gk[2 * j], c[2 * j + 1] * rc * gk[2 * j + 1]);
      const float k0 = bf_lo(wr[b]), k1 = bf_hi(wr[b]);
      const float p0 = __shfl_xor(k0, 16), p1 = __shfl_xor(k1, 16);
      const bool lo16 = (lane & 16) == 0;
      const float r0 = lo16 ? (k0 * cs[b][0] - p0 * cs[b][1]) : (p0 * cs[b][1] + k0 * cs[b][0]);
      const float r1 = lo16 ? (k1 * cs[b][2] - p1 * cs[b][3]) : (p1 * cs[b][3] + k1 * cs[b][2]);
      if (lane < 32) ((unsigned*)(KR + (size_t)(row0 + b) * 64))[lane] = pk2(r0, r1);
    }
  }
}

enum { OP_P0 = 0, OP_GEMM, OP_SCAN, OP_COMB, OP_ROW, OP_RN, OP_ATT };
constexpr int N_OPS = 28;
__device__ __forceinline__ int op_kind(int i) {
  switch (i) { case 0: return OP_P0; case 2: return OP_SCAN; case 3: return OP_COMB; case 13: return OP_RN; case 16: case 19: return OP_ATT;
    case 5: case 9: case 11: case 21: case 25: case 27: return OP_ROW; default: return OP_GEMM; }
}
__device__ __forceinline__ bool op_sync(int i) { return !(i == 7 || i == 14 || i == 17 || i == 23); }
#define WSB(off) ((bf16_t*)(ws + (off)))

#ifndef SCAN_REPS
#define SCAN_REPS 1
#endif
#ifndef GEMM_REPS
#define GEMM_REPS 1
#endif
template <int M, int N, int K, int MODE>
__device__ __forceinline__ void gemm_t(const bf16_t* A, const bf16_t* Bt, bf16_t* O, const bf16_t* E, float* part, unsigned char* lds) {
  pg8::Gemm g{A, Bt, M, N, K}; pg8::StaticOrder S; S.init(M, N, (int)gridDim.x, (int)blockIdx.x);
  pg8::EpiGen<MODE> Ep{O, N, part, E};
  pg8::gemm_phase<pg8::EpiGen<MODE>, pg8::StaticOrder, true, true>((PG8_LAS unsigned char*)lds, g, S, Ep);
  __syncthreads();
#if GEMM_REPS == 2
  pg8::gemm_phase<pg8::EpiGen<MODE>, pg8::StaticOrder, true, true>((PG8_LAS unsigned char*)lds, g, S, Ep);
  __syncthreads();
#endif
}
__device__ __forceinline__ void do_row(const Args& args, int opi, int gw, int ngw, int lane) {
  unsigned char* ws = args.ws; bf16_t* H16 = (bf16_t*)args.out;
  RowOp r; r.hin16 = H16; r.hout16 = H16; r.hin = nullptr; r.m = WSB(WS_B); r.part = (const float*)(ws + WS_PART); r.gpost = nullptr; r.hout = nullptr; r.aout = nullptr; r.gnext = nullptr; r.pin = nullptr; r.p16 = WSB(WS_P16);
  switch (opi) {
    case 5: r.hin16 = nullptr; r.hin = args.in[0]; r.gpost = args.in[4]; r.aout = WSB(WS_BIG0); r.gnext = args.in[5]; r.pin = args.in[1]; break;
    case 9: r.gpost = args.in[6]; break;
    case 11: r.gpost = args.in[11]; r.aout = WSB(WS_A); r.gnext = args.in[3] + DM; break;
    case 21: r.m = WSB(WS_M3); r.gpost = args.in[4] + DM; r.aout = WSB(WS_BIG0); r.gnext = args.in[5] + DM; r.pin = args.in[1] + (size_t)NT_ * 256; break;
    case 25: r.gpost = args.in[6] + DM; r.hout16 = WSB(WS_BIG0); break;
    default: r.hin16 = WSB(WS_BIG0); r.hout16 = nullptr; r.hout = args.out; r.gpost = args.in[11] + DM; break;
  }
  row_phase(r, gw, ngw, lane);
}

__device__ __forceinline__ void do_att(const Args& args, int half, int vcu, unsigned char* lds) {
  unsigned char* ws = args.ws; const float2* CS = (const float2*)(ws + WS_CS); const int G = gridDim.x;
  for (int u = vcu; u < 2048; u += G) {
    const int bh = u >> 4, qb = u & 15, bl = bh >> 4, h = bh & 15; const int bglob = half * 8 + bl;
    att::attn_unit(WSB(WS_QH) + ((size_t)bl * SEQ + qb * 256) * 3072 + h * 192, WSB(WS_KVH) + (size_t)bl * SEQ * 4096 + h * 256, WSB(WS_KR) + (size_t)bglob * SEQ * 64,
                   CS + ((size_t)bglob * SEQ + qb * 256) * 32, WSB(WS_A) + ((size_t)bglob * SEQ + qb * 256) * 2048 + h * 128, SEQ, (char*)lds);
  }
}

__device__ __forceinline__ void do_p0(const Args& args, int gw, int ngw, int lane, int wave, unsigned char* lds) {
  unsigned char* ws = args.ws;
  float* scr = (float*)lds + wave * (64 * 33);
  int base = 0;
#define TR(SRC, KK, NN, DST) do { const int items = ((KK) / 64) * ((NN) / 32); int first = (gw - base) % ngw; if (first < 0) first += ngw; \
    for (int it = first; it < items; it += ngw) transpose_item((SRC), (KK), (NN), WSB(DST), scr, it, lane); base += items; } while (0)
  TR(args.in[13], 1024, 5120, W_HGIN); TR(args.in[15], 1024, 1024, W_HGOUT);
  TR(args.in[7], 1024, 4096, W_UP); TR(args.in[7] + (size_t)DM * DFF, 1024, 4096, W_UP + 8 * MiB);
  TR(args.in[8], 4096, 1024, W_DN); TR(args.in[8] + (size_t)DM * DFF, 4096, 1024, W_DN + 8 * MiB);
  TR(args.in[9], 256, 1024, W_PP); TR(args.in[9] + 256 * DM, 256, 1024, W_PP + 512 * 1024);
  TR(args.in[10], 1024, 1024, W_PG); TR(args.in[10] + (size_t)DM * DM, 1024, 1024, W_PG + 2 * MiB);
  TR(args.in[16], 1024, 704, W_MLAIN); TR(args.in[18], 384, 3072, W_UQ); TR(args.in[20], 256, 4096, W_UKV); TR(args.in[21], 2048, 1024, W_O);
#undef TR
  for (int i = gw * 64 + lane; i < 64 * 1024 / 8; i += ngw * 64) *(u32x4*)(WSB(W_MLAIN) + (size_t)704 * 1024 + (size_t)i * 8) = (u32x4){0u, 0u, 0u, 0u};
  if (blockIdx.x == 0) { float* lbv = (float*)(ws + WS_LB); for (int c = threadIdx.x; c < 1024; c += 512) { const float* L = args.in[12]; const float l0 = L[c], l1 = L[1024 + c], l2 = L[2048 + c]; const float mx = fmaxf(l0, fmaxf(l1, l2));
      const float e0 = __expf(l0 - mx), e1 = __expf(l1 - mx), e2 = __expf(l2 - mx); lbv[c] = e0 / (e0 + e1 + e2); } }
  { float2* CS = (float2*)(ws + WS_CS); const int* positions = (const int*)args.in[2];
    for (int i = gw * 64 + lane; i < NT_ * 32; i += ngw * 64) { const int row = i >> 5, fi = i & 31;
      const float inv = 1.0f / exp2f((float)fi * (13.287712379549449f / 32.f)); const float ang = (float)positions[row] * inv;
      double rev = (double)ang * 0.15915494309189535; rev -= floor(rev); const float rf = (float)rev;
      CS[i] = make_float2(__builtin_amdgcn_cosf(rf), __builtin_amdgcn_sinf(rf)); } }
  RowOp r0; r0.hin16 = nullptr; r0.hout16 = nullptr; r0.hin = args.in[0]; r0.m = nullptr; r0.part = nullptr; r0.gpost = nullptr; r0.hout = nullptr; r0.aout = WSB(WS_A); r0.gnext = args.in[3]; r0.pin = nullptr; r0.p16 = nullptr;
  row_phase(r0, gw, ngw, lane);
}

__global__ void __launch_bounds__(512, 2) mega(Args args) {
  extern __shared__ __attribute__((aligned(16))) unsigned char lds[];
  cg::grid_group grid = cg::this_grid();
  const int lo = args.ph_lo, hi = args.ph_hi;
  if (lo < 0) grid.sync();
  { volatile LAS unsigned* st0 = (volatile LAS unsigned*)((LAS unsigned char*)lds + XB_LDS_OFF); if (threadIdx.x < 4) st0[threadIdx.x] = 0u; }
  __syncthreads();
  XcdBarrier xbar = xcd_barrier_post((unsigned*)(args.ws + WS_CTL), (volatile LAS unsigned*)((LAS unsigned char*)lds + XB_LDS_OFF));
#define IN(k) (lo <= (k) && (k) < hi)
#define SEAM(k) do { if ((k) + 1 < hi) { xcd_barrier(xbar); } } while (0)
#define FRAME const int tid = threadIdx.x, lane = tid & 63, wave = __builtin_amdgcn_readfirstlane(tid >> 6); const int G = gridDim.x, bx = blockIdx.x; \
    const int vcu = (G % 8 == 0) ? (bx % 8) * (G / 8) + bx / 8 : bx; const int gw = vcu * 8 + wave, ngw = G * 8; unsigned char* ws = args.ws; float* part = (float*)(ws + WS_PART); (void)lane; (void)gw; (void)ngw; (void)part; (void)ws;
#define ROWOP(k) if (IN(k)) { FRAME do_row(args, (k), gw, ngw, lane); SEAM(k); }
  if (IN(0)) { FRAME do_p0(args, gw, ngw, lane, wave, lds);
#ifdef DBL_P0
    __syncthreads(); do_p0(args, gw, ngw, lane, wave, lds);
#endif
    SEAM(0); }
  if (IN(1)) { FRAME gemm_t<NT_, 5120, 1024, 0>(WSB(WS_A), WSB(W_HGIN), WSB(WS_BIG0), nullptr, part, lds); SEAM(1); }
  if (IN(2)) { FRAME for (int rep = 0; rep < SCAN_REPS; ++rep) for (int c = vcu; c < 256; c += G) gla::scan_chain(WSB(WS_BIG0), (const float*)(ws + WS_LB), WSB(WS_A), WSB(WS_B), c, (char*)lds); SEAM(2); }
  if (IN(3)) { FRAME comb_phase(WSB(WS_A), WSB(WS_B), WSB(WS_BIG0), args.in[14], gw, ngw, lane); SEAM(3); }
  if (IN(4)) { FRAME gemm_t<NT_, 1024, 1024, 2>(WSB(WS_A), WSB(W_HGOUT), WSB(WS_B), nullptr, part, lds); SEAM(4); }
  if (IN(5)) { FRAME do_row(args, 5, gw, ngw, lane);
#ifdef DBL_ROW5
    do_row(args, 5, gw, ngw, lane);
#endif
    SEAM(5); }
  if (IN(6)) { FRAME gemm_t<NT_, 4096, 1024, 1>(WSB(WS_BIG0), WSB(W_UP), WSB(WS_HID), nullptr, part, lds); SEAM(6); }
  if (IN(7)) { FRAME gemm_t<NT_, 1024, 4096, 2>(WSB(WS_HID), WSB(W_DN), WSB(WS_B), nullptr, part, lds); }
  if (IN(8)) { FRAME gemm_t<NT_, 1024, 256, 0>(WSB(WS_P16), WSB(W_PP), WSB(WS_BIG0), nullptr, part, lds); SEAM(8); }
  ROWOP(9)
  if (IN(10)) { FRAME gemm_t<NT_, 1024, 1024, 3>((const bf16_t*)args.out, WSB(W_PG), WSB(WS_B), WSB(WS_BIG0), part, lds); SEAM(10); }
  ROWOP(11)
  if (IN(12)) { FRAME gemm_t<NT_, 768, 1024, 0>(WSB(WS_A), WSB(W_MLAIN), WSB(WS_B), nullptr, part, lds); SEAM(12); }
  if (IN(13)) { FRAME rn_phase(WSB(WS_B), args.in[17], args.in[19], (const float2*)(ws + WS_CS), WSB(WS_CQ), WSB(WS_CKV), WSB(WS_KR), gw, ngw, lane); SEAM(13); }
  if (IN(14)) { FRAME gemm_t<32768, 3072, 384, 0>(WSB(WS_CQ), WSB(W_UQ), WSB(WS_QH), nullptr, part, lds); }
  if (IN(15)) { FRAME gemm_t<32768, 4096, 256, 0>(WSB(WS_CKV), WSB(W_UKV), WSB(WS_KVH), nullptr, part, lds); SEAM(15); }
  if (IN(16)) { FRAME do_att(args, 0, vcu, lds);
#ifdef DBL_ATT
    do_att(args, 0, vcu, lds);
#endif
    SEAM(16); }
  if (IN(17)) { FRAME gemm_t<32768, 3072, 384, 0>(WSB(WS_CQ) + (size_t)32768 * 384, WSB(W_UQ), WSB(WS_QH), nullptr, part, lds); }
  if (IN(18)) { FRAME gemm_t<32768, 4096, 256, 0>(WSB(WS_CKV) + (size_t)32768 * 256, WSB(W_UKV), WSB(WS_KVH), nullptr, part, lds); SEAM(18); }
  if (IN(19)) { FRAME do_att(args, 1, vcu, lds);
#ifdef DBL_ATT
    do_att(args, 1, vcu, lds);
#endif
    SEAM(19); }
  if (IN(20)) { FRAME gemm_t<NT_, 1024, 2048, 2>(WSB(WS_A), WSB(W_O), WSB(WS_M3), nullptr, part, lds); SEAM(20); }
  ROWOP(21)
  if (IN(22)) { FRAME gemm_t<NT_, 4096, 1024, 1>(WSB(WS_BIG0), WSB(W_UP + 8 * MiB), WSB(WS_HID), nullptr, part, lds); SEAM(22); }
  if (IN(23)) { FRAME gemm_t<NT_, 1024, 4096, 2>(WSB(WS_HID), WSB(W_DN + 8 * MiB), WSB(WS_B), nullptr, part, lds); }
  if (IN(24)) { FRAME gemm_t<NT_, 1024, 256, 0>(WSB(WS_P16), WSB(W_PP + 512 * 1024), WSB(WS_A), nullptr, part, lds); SEAM(24); }
  ROWOP(25)
  if (IN(26)) { FRAME gemm_t<NT_, 1024, 1024, 3>(WSB(WS_BIG0), WSB(W_PG + 2 * MiB), WSB(WS_B), WSB(WS_A), part, lds); SEAM(26); }
  ROWOP(27)
#ifdef DUMP_MODE
  { FRAME asm volatile("s_waitcnt vmcnt(0) lgkmcnt(0)" ::: "memory"); __builtin_amdgcn_fence(__ATOMIC_RELEASE, "agent"); grid.sync(); __builtin_amdgcn_fence(__ATOMIC_ACQUIRE, "agent");
    for (size_t i = (size_t)bx * 512 + tid; i < (size_t)NT_ * DM; i += (size_t)G * 512) { const size_t row = i >> 10, c = i & 1023; float v = 0.f;
      if (DUMP_MODE == 1) v = bf_lo(WSB(WS_A)[i]);
      else if (DUMP_MODE == 2) { for (int j = 0; j < 5; ++j) v += bf_lo(WSB(WS_BIG0)[row * 5120 + c + 1024 * j]); }
      else if (DUMP_MODE == 3) v = bf_lo(WSB(WS_A)[i]) + bf_lo(WSB(WS_B)[i]);
      else if (DUMP_MODE == 4) v = bf_lo(WSB(WS_B)[i]);
      if (!(fabsf(v) < 1e30f)) v = 12345.f;
      args.out[i] = v; } }
#endif
#undef IN
#undef SEAM
#undef FRAME
#undef ROWOP
}
#undef WSB

#ifndef N_LAUNCH_MODE
#define N_LAUNCH_MODE 0
#endif
extern "C" void kernel_launch(void* const* d_in, const int* in_sizes, int n_in, void* d_out, int out_size, void* d_ws, size_t ws_size, hipStream_t stream) {
  static int grid = 0;
  if (grid == 0) {
    if (n_in != 22 || out_size != NT_ * DM || ws_size < WS_NEED) { fprintf(stderr, "kernel_launch: unexpected shapes n_in %d out %d ws %zu\n", n_in, out_size, ws_size); grid = -1; return; }
    int dev = 0, cus = 0, per_cu = 0;
    hipGetDevice(&dev); hipDeviceGetAttribute(&cus, hipDeviceAttributeMultiprocessorCount, dev);
    if (hipFuncSetAttribute((const void*)mega, hipFuncAttributeMaxDynamicSharedMemorySize, LDS_BYTES) != hipSuccess) { fprintf(stderr, "kernel_launch: hipFuncSetAttribute failed\n"); grid = -1; return; }
    if (hipOccupancyMaxActiveBlocksPerMultiprocessor(&per_cu, (const void*)mega, 512, LDS_BYTES) != hipSuccess || per_cu < 1) { fprintf(stderr, "kernel_launch: occupancy query gives %d\n", per_cu); per_cu = 1; }
    (void)hipGetLastError();
    grid = cus * 1;
  }
  if (grid < 0) return;
  Args a{};
  for (int i = 0; i < 22; ++i) a.in[i] = (const float*)d_in[i];
  a.out = (float*)d_out; a.ws = (unsigned char*)d_ws;
  if (hipMemsetAsync((char*)d_ws + WS_CTL, 0, CTL_BYTES, stream) != hipSuccess) { fprintf(stderr, "kernel_launch: memset failed\n"); return; }
#if N_LAUNCH_MODE == 0
#ifndef STOP_AT
#define STOP_AT N_OPS
#endif
  a.ph_lo = 0; a.ph_hi = STOP_AT;
  void* kargs[] = {&a};
  hipError_t e = hipLaunchCooperativeKernel((const void*)mega, dim3(grid), dim3(512), kargs, LDS_BYTES, stream);
  if (e != hipSuccess) fprintf(stderr, "cooperative launch failed: %s (grid %d)\n", hipGetErrorString(e), grid);
#else
  const int cuts[] = {0, 1, 2, 3, 4, 5, 6, 7, 9, 10, 11, 12, 13, 14, 16, 17, 19, 20, 21, 22, 23, 25, 26, 27, 28};
  for (unsigned i = 0; i + 1 < sizeof(cuts) / sizeof(int); ++i) { a.ph_lo = cuts[i]; a.ph_hi = cuts[i + 1]; hipLaunchKernelGGL(mega, dim3(grid), dim3(512), LDS_BYTES, stream, a); }
#endif
}
```

```cpp
#include <hip/hip_runtime.h>
#include <hip/hip_cooperative_groups.h>
#include <cstdio>
#include <cstdint>
namespace cg = cooperative_groups;
namespace pg8 {
#define PG8_LAS __attribute__((address_space(3)))
typedef unsigned short bf16_t;
typedef short bf16x8 __attribute__((ext_vector_type(8)));
typedef float f32x4 __attribute__((ext_vector_type(4)));
typedef unsigned u32x4 __attribute__((ext_vector_type(4)));
constexpr int BM = 256, BK = 64, HALF = 128, HTB = HALF * BK * 2  , STAGE_BYTES = 8 * HTB, NXCD = 8, WGM = 4;

__host__ __device__ __forceinline__ int lds_byte(int r, int c) { const int st = (r >> 4) * 2 + (c >> 5), rr = r & 15, cc = c & 31, ob = rr * 64 + cc * 2; return st * 1024 + (ob ^ (((ob >> 9) & 1) << 5)); }
__host__ __device__ __forceinline__ void stage_rc(int b, int& R, int& C) { const int st = b / 1024, sb = b % 1024, swz = sb ^ (((sb >> 9) & 1) << 5); R = (st >> 1) * 16 + swz / 64; C = (st & 1) * 32 + (swz % 64) / 2; }
__host__ __device__ __forceinline__ int perm32(int rho) { const int n = rho >> 4, i = rho & 15; return 8 * (i >> 2) + 4 * n + (i & 3); }

struct Unit { int pm, pn; };
struct Gemm { const bf16_t* A; const bf16_t* Bt; int M, N, K; };

struct StaticOrder {
    int nM, nN, nwg, G, c;
    __host__ __device__ void init(int M, int N, int G_, int c_) { nM = M / BM; nN = N / BM; nwg = nM * nN; G = G_; c = c_; }
    __host__ __device__ bool next(int i, Unit& u) const {
        const long L = (long)i * G + c; if (L >= nwg) return false;
        int wgid = (int)L; { const int q = nwg / NXCD, r = nwg % NXCD, xcd = wgid % NXCD, off = wgid / NXCD; wgid = (xcd < r ? xcd * (q + 1) : r * (q + 1) + (xcd - r) * q) + off; }
        const int nig = WGM * nN, gid = wgid / nig, fm = gid * WGM, gsz = (nM - fm) < WGM ? (nM - fm) : WGM;
        u.pm = fm + ((wgid % nig) % gsz); u.pn = (wgid % nig) / gsz; return true;
    }
    __device__ __forceinline__ void a_ready(const Unit&) const {}
    __device__ __forceinline__ void done(const Unit&) const {}
};

__device__ __forceinline__ unsigned cvt_pk_bf16(float lo, float hi) { unsigned r; asm volatile("v_cvt_pk_bf16_f32 %0, %1, %2" : "=v"(r) : "v"(lo), "v"(hi)); return r; }
typedef float f32x2_t __attribute__((ext_vector_type(2))); typedef __bf16 bf16x2_t __attribute__((ext_vector_type(2)));
__device__ __forceinline__ unsigned cvt_pk_safe(float lo, float hi) { f32x2_t v = {lo, hi}; bf16x2_t b = __builtin_convertvector(v, bf16x2_t); return __builtin_bit_cast(unsigned, b); }
template <int mode> struct EpiGen {
    static constexpr bool PERM = true, AFTER_DRAIN = false;
    bf16_t* O; int ldc; float* part; const bf16_t* E;
    __device__ __forceinline__ void operator()(const f32x4 (&acc)[2][2][4][2], const Unit& u, int wr, int wc, int fr, int fq) const {
        const int row0 = u.pm * BM + wr * 64 + fr, col0 = u.pn * BM + wc * 32 + 8 * fq;
#pragma unroll
        for (int ai = 0; ai < 2; ++ai)
#pragma unroll
            for (int m = 0; m < 4; ++m) {
                const int row = row0 + ai * HALF + m * 16;
                bf16_t* rowp = O + (size_t)row * ldc + col0;
                float ss = 0.f;
                const float rsc = (mode >= 6) ? part[row] : 1.f;
#pragma unroll
                for (int bj = 0; bj < 2; ++bj) {
                    f32x4 v0 = acc[ai][bj][m][0], v1 = acc[ai][bj][m][1];
                    if (mode >= 6) { v0 = v0 * rsc; v1 = v1 * rsc; }
                    if (mode == 1 || mode == 6) {
#pragma unroll
                        for (int i = 0; i < 4; ++i) { float a = fmaxf(v0[i], 0.f), b = fmaxf(v1[i], 0.f); v0[i] = a * a; v1[i] = b * b; }
                    } else if (mode == 3) {
                        const u32x4 e = *(const u32x4*)(E + (size_t)row * ldc + col0 + bj * HALF);
                        float ef[8];
#pragma unroll
                        for (int i = 0; i < 4; ++i) { ef[2 * i] = __uint_as_float(e[i] << 16); ef[2 * i + 1] = __uint_as_float(e[i] & 0xffff0000u); }
#pragma unroll
                        for (int i = 0; i < 4; ++i) { v0[i] = ef[i] / (1.f + __expf(-v0[i])); v1[i] = ef[4 + i] / (1.f + __expf(-v1[i])); }
                    }
                    if (mode == 2 || mode == 3) ss += (v0[0] * v0[0] + v0[1] * v0[1]) + (v0[2] * v0[2] + v0[3] * v0[3]) + (v1[0] * v1[0] + v1[1] * v1[1]) + (v1[2] * v1[2] + v1[3] * v1[3]);
                    u32x4 w; w.x = cvt_pk_safe(v0[0], v0[1]); w.y = cvt_pk_safe(v0[2], v0[3]); w.z = cvt_pk_safe(v1[0], v1[1]); w.w = cvt_pk_safe(v1[2], v1[3]);
                    *(u32x4*)(rowp + bj * HALF) = w;
                }
                if (mode == 2 || mode == 3) { ss += __shfl_xor(ss, 16); ss += __shfl_xor(ss, 32); if (fq == 0) part[(size_t)row * 16 + u.pn * 4 + wc] = ss; }
            }
    }
};
template <class Epi, class Sched, bool ALIGN_EPI = false, bool SP2 = false>
__device__ __forceinline__ void gemm_phase(PG8_LAS unsigned char* lds, const Gemm g, const Sched& S, const Epi& E) {
    const int tid = threadIdx.x, wid = __builtin_amdgcn_readfirstlane(tid >> 6), lane = tid & 63, wr = wid >> 2, wc = wid & 3, fr = lane & 15, fq = lane >> 4;
    const int K = g.K, nt = K / BK;
    unsigned voffA[2], voffB[2];
#pragma unroll
    for (int i = 0; i < 2; ++i) { int R, C; stage_rc(tid * 16 + i * 8192, R, C); const int Rb = Epi::PERM ? ((R & ~31) + perm32(R & 31)) : R;
        voffA[i] = (unsigned)(R * K + C) * 2u; voffB[i] = (unsigned)(Rb * K + C) * 2u; }
    const size_t kstep = (size_t)(BK * 2);
    const size_t hstep = (size_t)HALF * K * 2;
    const size_t tstep = 2 * hstep;
    const unsigned ldsw = (unsigned)wid * 1024u;
    const int aoff = lds_byte(wr * 64 + fr, fq * 8), boff = lds_byte(wc * 32 + fr, fq * 8);
#define PG8_SA(b, h) (((b) * 2 + (h)) * HTB)
#define PG8_SB(b, h) ((4 + (b) * 2 + (h)) * HTB)
#define PG8_STAGE(bufoff, gbase, voff) do { _Pragma("unroll") for (int _i = 0; _i < 2; ++_i) \
        __builtin_amdgcn_global_load_lds((const unsigned*)((const char*)(gbase) + (voff)[_i]), (PG8_LAS unsigned*)(lds + (bufoff) + ldsw + _i * 8192), 16, 0, 0); } while (0)
#define PG8_LDA(dst, b, h) do { _Pragma("unroll") for (int m = 0; m < 4; ++m) _Pragma("unroll") for (int k = 0; k < 2; ++k) dst[m][k] = *(const PG8_LAS bf16x8*)(lds + PG8_SA(b, h) + aoff + m * 2048 + k * 1024); } while (0)
#define PG8_LDB(dst, b, h) do { _Pragma("unroll") for (int n = 0; n < 2; ++n) _Pragma("unroll") for (int k = 0; k < 2; ++k) dst[n][k] = *(const PG8_LAS bf16x8*)(lds + PG8_SB(b, h) + boff + n * 2048 + k * 1024); } while (0)
#define PG8_MMA(ai, bj, At, Bt) do { __builtin_amdgcn_s_setprio(1); _Pragma("unroll") for (int m = 0; m < 4; ++m) _Pragma("unroll") for (int n = 0; n < 2; ++n) _Pragma("unroll") for (int k = 0; k < 2; ++k) \
        acc[ai][bj][m][n] = __builtin_amdgcn_mfma_f32_16x16x32_bf16(Bt[n][k], At[m][k], acc[ai][bj][m][n], 0, 0, 0); __builtin_amdgcn_s_setprio(0); } while (0)
#define PG8_WAIT_V(n) asm volatile("s_waitcnt vmcnt(" #n ")" ::: "memory")
#define PG8_WAIT_L(n) asm volatile("s_waitcnt lgkmcnt(" #n ")" ::: "memory")
#define PG8_BAR __builtin_amdgcn_s_barrier()
#define PG8_SCHED __builtin_amdgcn_sched_barrier(0)
    Unit cur, nxt; int ui = 0;
    if (!S.next(0, cur)) return;
    f32x4 acc[2][2][4][2];
#pragma unroll
    for (int a = 0; a < 2; ++a)
#pragma unroll
        for (int b = 0; b < 2; ++b)
#pragma unroll
            for (int m = 0; m < 4; ++m)
#pragma unroll
                for (int n = 0; n < 2; ++n) acc[a][b][m][n] = (f32x4){0.f, 0.f, 0.f, 0.f};
    bf16x8 At[4][2], B0[2][2], B1[2][2];
    const char* cA = (const char*)g.A + (size_t)cur.pm * tstep; const char* cB = (const char*)g.Bt + (size_t)cur.pn * tstep;
    S.a_ready(cur);
    if constexpr (SP2) {
        PG8_STAGE(PG8_SB(0, 0), cB, voffB); PG8_STAGE(PG8_SB(0, 1), cB + hstep, voffB); PG8_STAGE(PG8_SA(0, 0), cA, voffA); PG8_STAGE(PG8_SA(0, 1), cA + hstep, voffA);
        if (wr == 1) PG8_BAR;
        PG8_WAIT_V(2); PG8_BAR;
        PG8_STAGE(PG8_SB(1, 0), cB + kstep, voffB); PG8_STAGE(PG8_SA(1, 0), cA + kstep, voffA); PG8_STAGE(PG8_SB(1, 1), cB + hstep + kstep, voffB);
        PG8_WAIT_V(6); PG8_BAR;
    } else {
        PG8_STAGE(PG8_SB(0, 0), cB, voffB); PG8_STAGE(PG8_SA(0, 0), cA, voffA); PG8_STAGE(PG8_SB(0, 1), cB + hstep, voffB); PG8_STAGE(PG8_SA(0, 1), cA + hstep, voffA);
        if (wr == 1) PG8_BAR;
        PG8_WAIT_V(4); PG8_BAR;
        PG8_STAGE(PG8_SB(1, 0), cB + kstep, voffB); PG8_STAGE(PG8_SA(1, 0), cA + kstep, voffA); PG8_STAGE(PG8_SB(1, 1), cB + hstep + kstep, voffB);
        PG8_WAIT_V(6); PG8_BAR;
    }
    for (;;) {
        const bool has_next = S.next(ui + 1, nxt);
        const char* nA = has_next ? (const char*)g.A + (size_t)nxt.pm * tstep : cA; const char* nB = has_next ? (const char*)g.Bt + (size_t)nxt.pn * tstep : cB;
        for (int t = 0; t < nt; t += 2) {
            const bool last = (t == nt - 2);
            const char* a1 = cA + (size_t)(t + 1) * kstep;
            const char* a2 = last ? nA : cA + (size_t)(t + 2) * kstep; const char* b2 = last ? nB : cB + (size_t)(t + 2) * kstep;
            const char* a3 = a2 + kstep; const char* b3 = b2 + kstep;
            if (last && has_next) S.a_ready(nxt);
            if constexpr (SP2) {
            PG8_LDB(B0, 0, 0); PG8_LDB(B1, 0, 1); PG8_SCHED; PG8_LDA(At, 0, 0); PG8_STAGE(PG8_SA(1, 1), a1 + hstep, voffA);
            PG8_WAIT_V(8); PG8_WAIT_L(0); PG8_BAR; PG8_MMA(0, 0, At, B0); PG8_MMA(0, 1, At, B1); PG8_BAR; PG8_SCHED;
            PG8_LDA(At, 0, 1); PG8_STAGE(PG8_SB(0, 0), b2, voffB); PG8_STAGE(PG8_SB(0, 1), b2 + hstep, voffB); PG8_STAGE(PG8_SA(0, 0), a2, voffA);
            PG8_WAIT_V(8); PG8_WAIT_L(0); PG8_BAR; PG8_MMA(1, 0, At, B0); PG8_MMA(1, 1, At, B1); PG8_BAR; PG8_SCHED;
            PG8_LDB(B0, 1, 0); PG8_LDB(B1, 1, 1); PG8_SCHED; PG8_LDA(At, 1, 0); PG8_STAGE(PG8_SA(0, 1), a2 + hstep, voffA);
            PG8_WAIT_V(8); PG8_WAIT_L(0); PG8_BAR; PG8_MMA(0, 0, At, B0); PG8_MMA(0, 1, At, B1); PG8_BAR; PG8_SCHED;
            PG8_LDA(At, 1, 1); PG8_STAGE(PG8_SB(1, 0), b3, voffB); PG8_STAGE(PG8_SB(1, 1), b3 + hstep, voffB); PG8_STAGE(PG8_SA(1, 0), a3, voffA);
            PG8_WAIT_V(8); PG8_WAIT_L(0); PG8_BAR; PG8_MMA(1, 0, At, B0); PG8_MMA(1, 1, At, B1); PG8_BAR; PG8_SCHED;
            } else {
            PG8_LDB(B0, 0, 0); PG8_SCHED; PG8_LDA(At, 0, 0); PG8_STAGE(PG8_SA(1, 1), a1 + hstep, voffA);
            PG8_WAIT_L(8); PG8_BAR; PG8_WAIT_L(0); PG8_MMA(0, 0, At, B0); PG8_BAR; PG8_SCHED;
            PG8_LDB(B1, 0, 1); PG8_STAGE(PG8_SB(0, 0), b2, voffB);
            PG8_BAR; PG8_WAIT_L(0); PG8_MMA(0, 1, At, B1); PG8_BAR;
            PG8_LDA(At, 0, 1); PG8_STAGE(PG8_SA(0, 0), a2, voffA);
            PG8_BAR; PG8_WAIT_L(0); PG8_MMA(1, 0, At, B0); PG8_BAR; PG8_SCHED;
            PG8_STAGE(PG8_SB(0, 1), b2 + hstep, voffB);
            PG8_WAIT_V(6); PG8_BAR; PG8_MMA(1, 1, At, B1); PG8_BAR;
            PG8_LDB(B0, 1, 0); PG8_SCHED; PG8_LDA(At, 1, 0); PG8_STAGE(PG8_SA(0, 1), a2 + hstep, voffA);
            PG8_WAIT_L(8); PG8_BAR; PG8_WAIT_L(0); PG8_MMA(0, 0, At, B0); PG8_BAR; PG8_SCHED;
            PG8_LDB(B1, 1, 1); PG8_STAGE(PG8_SB(1, 0), b3, voffB);
            PG8_BAR; PG8_WAIT_L(0); PG8_MMA(0, 1, At, B1); PG8_BAR;
            PG8_LDA(At, 1, 1); PG8_STAGE(PG8_SA(1, 0), a3, voffA);
            PG8_BAR; PG8_WAIT_L(0); PG8_MMA(1, 0, At, B0); PG8_BAR; PG8_SCHED;
            PG8_STAGE(PG8_SB(1, 1), b3 + hstep, voffB);
            PG8_WAIT_V(6); PG8_BAR; PG8_MMA(1, 1, At, B1); PG8_BAR;
            }
        }
        if constexpr (ALIGN_EPI) { if (wr == 0) PG8_BAR; }
        if constexpr (!Epi::AFTER_DRAIN) { E(acc, cur, wr, wc, fr, fq); S.done(cur); }
        if (!has_next) break;
#pragma unroll
        for (int a = 0; a < 2; ++a)
#pragma unroll
            for (int b = 0; b < 2; ++b)
#pragma unroll
                for (int m = 0; m < 4; ++m)
#pragma unroll
                    for (int n = 0; n < 2; ++n) acc[a][b][m][n] = (f32x4){0.f, 0.f, 0.f, 0.f};
        cur = nxt; cA = nA; cB = nB; ++ui;
        if constexpr (ALIGN_EPI) { if (wr == 1) PG8_BAR; }
    }
    PG8_WAIT_V(0);
    if constexpr (!ALIGN_EPI) { if (wr == 0) PG8_BAR; }
    PG8_BAR;
    if constexpr (Epi::AFTER_DRAIN) { E.fused(acc, cur, wr, wc, fr, fq, lds, wid, lane); S.done(cur); }
#undef PG8_SA
#undef PG8_SB
#undef PG8_STAGE
#undef PG8_LDA
#undef PG8_LDB
#undef PG8_MMA
#undef PG8_WAIT_V
#undef PG8_WAIT_L
#undef PG8_BAR
#undef PG8_SCHED
}
}
namespace att {
typedef unsigned short bf16_t;
using bf16x8 = __attribute__((ext_vector_type(8))) short;
using s16x4  = __attribute__((ext_vector_type(4))) short;
using f32x16 = __attribute__((ext_vector_type(16))) float;
using u32x4  = __attribute__((ext_vector_type(4))) unsigned;
constexpr int NW = 8, QBLK = 32, KVBLK = 64;
constexpr float SCALE = 0.07216878364870323f;
constexpr float THR = 8.f;
#ifndef ATT_SDEPTH
#define ATT_SDEPTH 1
#endif
constexpr int SDEPTH = ATT_SDEPTH;
constexpr int LDQ = 3072, LDK = 4096, LDKR = 64, LDO = 2048;
constexpr int SHM_V = KVBLK * 128 * 2, SHM_K = KVBLK * 400, SHM_QR = 2 * SHM_V + 2 * SHM_K + NW * 64 * 4, SHM_ATTN = SHM_QR + NW * 4096;
#define KSWZ(row, colB) ((row) * 400 + (colB))
#define SBAR() __builtin_amdgcn_sched_barrier(0)
__device__ __forceinline__ int crow(int r, int hi) { return (r & 3) + 8 * (r >> 2) + 4 * hi; }
__device__ __forceinline__ unsigned cvtpk(float lo, float hi) { unsigned r; asm volatile("v_cvt_pk_bf16_f32 %0, %1, %2" : "=v"(r) : "v"(lo), "v"(hi)); return r; }
__device__ __forceinline__ bf16x8 ld8(const bf16_t* p) { return *reinterpret_cast<const bf16x8*>(p); }

__device__ __forceinline__ void partialSM(f32x16& p0, f32x16& p1, float& m_reg, float& mn, float& alpha) {
  constexpr float C = SCALE * 1.4426950408889634f;
  float pmax = p0[0];
#pragma unroll
  for (int r = 1; r < 16; ++r) pmax = fmaxf(pmax, p0[r]);
#pragma unroll
  for (int r = 0; r < 16; ++r) pmax = fmaxf(pmax, p1[r]);
  { auto rr = __builtin_amdgcn_permlane32_swap(__float_as_uint(pmax), __float_as_uint(pmax), false, false);
    pmax = fmaxf(__uint_as_float(rr[0]), __uint_as_float(rr[1])); }
  if (__builtin_expect(__all(pmax - m_reg <= THR / SCALE), 1)) { mn = m_reg; alpha = 1.f; }
  else { mn = fmaxf(m_reg, pmax); alpha = __builtin_amdgcn_exp2f((m_reg - mn) * C); m_reg = mn; }
  float mnC = -mn * C;
#pragma unroll
  for (int r = 0; r < 16; ++r) p0[r] = fmaf(p0[r], C, mnC);
#pragma unroll
  for (int r = 0; r < 16; ++r) p1[r] = fmaf(p1[r], C, mnC);
#pragma unroll
  for (int r = 0; r < 16; ++r) p0[r] = __builtin_amdgcn_exp2f(p0[r]);
}
__device__ __forceinline__ void finishSM(f32x16& p0, f32x16& p1, float alpha, float& l_reg, bf16x8& pa0, bf16x8& pa1, bf16x8& pa2, bf16x8& pa3) {
#pragma unroll
  for (int r = 0; r < 16; ++r) p1[r] = __builtin_amdgcn_exp2f(p1[r]);
  float ps = 0;
#pragma unroll
  for (int r = 0; r < 16; ++r) ps += p0[r];
#pragma unroll
  for (int r = 0; r < 16; ++r) ps += p1[r];
  { auto rr = __builtin_amdgcn_permlane32_swap(__float_as_uint(ps), __float_as_uint(ps), false, false);
    ps = __uint_as_float(rr[0]) + __uint_as_float(rr[1]); }
  l_reg = l_reg * alpha + ps;
#define PK4(P, BASE, OUT) do { unsigned a0 = cvtpk(P[BASE + 0], P[BASE + 1]), a1 = cvtpk(P[BASE + 2], P[BASE + 3]);   \
    unsigned b0 = cvtpk(P[BASE + 4], P[BASE + 5]), b1 = cvtpk(P[BASE + 6], P[BASE + 7]);                              \
    auto r0 = __builtin_amdgcn_permlane32_swap(a0, b0, false, false); auto r1 = __builtin_amdgcn_permlane32_swap(a1, b1, false, false); \
    u32x4 w = {r0[0], r1[0], r0[1], r1[1]}; OUT = *reinterpret_cast<bf16x8*>(&w); } while (0)
  PK4(p0, 0, pa0); PK4(p0, 8, pa1); PK4(p1, 0, pa2); PK4(p1, 8, pa3);
#undef PK4
}
__device__ __forceinline__ void qkt(f32x16& p0, f32x16& p1, const char* Ks, const bf16x8* qr, const char* qrl, int r32, int hi) {
  p0 = f32x16{}; p1 = f32x16{};
#pragma unroll
  for (int d0 = 0; d0 < 12; ++d0) { int cb = (d0 * 16 + hi * 8) * 2;
    bf16x8 b0 = *reinterpret_cast<const bf16x8*>(Ks + r32 * 400 + hi * 16 + d0 * 32);
    bf16x8 b1 = *reinterpret_cast<const bf16x8*>(Ks + r32 * 400 + hi * 16 + d0 * 32 + 32 * 400);
    const bf16x8 qf = (d0 < 8) ? qr[d0 < 8 ? d0 : 0] : *reinterpret_cast<const bf16x8*>(qrl + (d0 - 8) * 1024);
    p0 = __builtin_amdgcn_mfma_f32_32x32x16_bf16(b0, qf, p0, 0, 0, 0);
    p1 = __builtin_amdgcn_mfma_f32_32x32x16_bf16(b1, qf, p1, 0, 0, 0); }
}
__device__ __forceinline__ int v_st(int k, int c) { const int kk = (k & ~0xC) | ((k & 4) << 1) | ((k & 8) >> 1); return ((kk >> 3) * 4 + (c >> 5)) * 512 + ((kk & 7) * 32 + (c & 31)) * 2; }
__device__ __forceinline__ int v_rd_base(int lane) { return ((lane & 3) << 3) | (((lane >> 2) & 3) << 6) | (((lane >> 4) & 1) << 5) | (((lane >> 5) & 1) << 8); }
constexpr int v_rd_off(int d0, int ks, int half) { return d0 * 512 + ks * 4096 + half * 2048; }
template <int OFF> __device__ __forceinline__ s16x4 tr_read(int vb) {
  s16x4 r; asm volatile("ds_read_b64_tr_b16 %0, %1 offset:%2" : "=&v"(r) : "v"(vb), "i"(OFF) : "memory"); return r;
}
template <int D0> __device__ __forceinline__ void pv_one(f32x16& od, int vb, bf16x8 pa0, bf16x8 pa1, bf16x8 pa2, bf16x8 pa3) {
  const s16x4 l0 = tr_read<v_rd_off(D0, 0, 0)>(vb), h0 = tr_read<v_rd_off(D0, 0, 1)>(vb), l1 = tr_read<v_rd_off(D0, 1, 0)>(vb), h1 = tr_read<v_rd_off(D0, 1, 1)>(vb);
  const s16x4 l2 = tr_read<v_rd_off(D0, 2, 0)>(vb), h2 = tr_read<v_rd_off(D0, 2, 1)>(vb), l3 = tr_read<v_rd_off(D0, 3, 0)>(vb), h3 = tr_read<v_rd_off(D0, 3, 1)>(vb);
  asm volatile("s_waitcnt lgkmcnt(0)" ::: "memory"); SBAR();
#define PK(L, H) (bf16x8){L[0], L[1], L[2], L[3], H[0], H[1], H[2], H[3]}
  od = __builtin_amdgcn_mfma_f32_32x32x16_bf16(pa0, PK(l0, h0), od, 0, 0, 0);
  od = __builtin_amdgcn_mfma_f32_32x32x16_bf16(pa1, PK(l1, h1), od, 0, 0, 0);
  od = __builtin_amdgcn_mfma_f32_32x32x16_bf16(pa2, PK(l2, h2), od, 0, 0, 0);
  od = __builtin_amdgcn_mfma_f32_32x32x16_bf16(pa3, PK(l3, h3), od, 0, 0, 0);
#undef PK
}
__device__ __forceinline__ void pv_d0(f32x16* o, int vb, bf16x8 pa0, bf16x8 pa1, bf16x8 pa2, bf16x8 pa3) {
  pv_one<0>(o[0], vb, pa0, pa1, pa2, pa3); pv_one<1>(o[1], vb, pa0, pa1, pa2, pa3); pv_one<2>(o[2], vb, pa0, pa1, pa2, pa3); pv_one<3>(o[3], vb, pa0, pa1, pa2, pa3);
}
__device__ __forceinline__ float bf2f(short x) { return __uint_as_float(((unsigned)(unsigned short)x) << 16); }

__device__ __forceinline__ void attn_unit(const bf16_t* __restrict__ Qb, const bf16_t* __restrict__ Kh, const bf16_t* __restrict__ KRb, const float2* __restrict__ CSb,
                                          bf16_t* __restrict__ Ob, int seq, char* lds) {
  const int tid = threadIdx.x, wid = tid >> 6, lane = tid & 63, r32 = lane & 31, hi = lane >> 5;
  const bf16_t* Vh = Kh + 128;
  char* V_lds = lds; char* K_lds = lds + 2 * SHM_V;
  float* ws = (float*)(lds + 2 * SHM_V + 2 * SHM_K) + wid * 64; float* li_l = ws; float* al_l = ws + 32;
  float m_reg = -1e30f, l_reg = 0; f32x16 o[4] = {}; bf16x8 qr[8]; char* qrl = lds + SHM_QR + wid * 4096 + lane * 16;
  const bf16_t* Qw = Qb + (long)(wid * QBLK + r32) * LDQ + hi * 8;
#pragma unroll
  for (int d0 = 0; d0 < 8; ++d0) qr[d0] = ld8(Qw + d0 * 16);
  {
    const float2* cs = CSb + (long)(wid * QBLK + r32) * 32 + hi * 8;
#pragma unroll
    for (int dd = 0; dd < 2; ++dd) {
      const bf16x8 qa = ld8(Qw + (8 + dd) * 16), qb2 = ld8(Qw + (10 + dd) * 16);
      float o1[8], o2[8];
#pragma unroll
      for (int j = 0; j < 8; ++j) { const float2 c = cs[dd * 16 + j]; const float t1 = bf2f(qa[j]), t2 = bf2f(qb2[j]);
        o1[j] = t1 * c.x - t2 * c.y; o2[j] = t1 * c.y + t2 * c.x; }
      u32x4 w1 = {cvtpk(o1[0], o1[1]), cvtpk(o1[2], o1[3]), cvtpk(o1[4], o1[5]), cvtpk(o1[6], o1[7])};
      u32x4 w2 = {cvtpk(o2[0], o2[1]), cvtpk(o2[2], o2[3]), cvtpk(o2[4], o2[5]), cvtpk(o2[6], o2[7])};
      *reinterpret_cast<u32x4*>(qrl + dd * 1024) = w1; *reinterpret_cast<u32x4*>(qrl + (2 + dd) * 1024) = w2;
    }
  }
  const int sr = tid >> 4, sc = (tid & 15) * 8, vst0 = v_st(sr, sc);
  const int rr_ = tid >> 3, rc_ = (tid & 7) * 8;
  const int vb0 = (int)(uintptr_t)V_lds + v_rd_base(lane);
  struct { bf16x8 vs0, vs1, ks0, ks1, kr; } sr_[SDEPTH];
  const unsigned toff = (unsigned)(sr * LDK + sc), troff = (unsigned)(rr_ * LDKR + rc_);
#define SLOAD(i, k0) do { const bf16_t* kb_ = Kh + (size_t)(k0) * LDK; const bf16_t* rb_ = KRb + (size_t)(k0) * LDKR; \
    sr_[i].vs0 = ld8(kb_ + 128 + toff); sr_[i].vs1 = ld8(kb_ + 32 * LDK + 128 + toff); \
    sr_[i].ks0 = ld8(kb_ + toff); sr_[i].ks1 = ld8(kb_ + 32 * LDK + toff); \
    sr_[i].kr = ld8(rb_ + troff); } while (0)
  const int kst0 = KSWZ(sr, sc * 2), krst = KSWZ(rr_, 256 + rc_ * 2);
#define SWRITE(b, i) do { *(bf16x8*)(V_lds + (b) * SHM_V + vst0) = sr_[i].vs0;          \
    *(bf16x8*)(V_lds + (b) * SHM_V + 8192 + vst0) = sr_[i].vs1;               \
    *(bf16x8*)(K_lds + (b) * SHM_K + kst0) = sr_[i].ks0;                       \
    *(bf16x8*)(K_lds + (b) * SHM_K + 32 * 400 + kst0) = sr_[i].ks1;                  \
    *(bf16x8*)(K_lds + (b) * SHM_K + krst) = sr_[i].kr; } while (0)
#define SWAIT() do { if constexpr (SDEPTH == 2) asm volatile("s_waitcnt vmcnt(5)" ::: "memory"); else asm volatile("s_waitcnt vmcnt(0)" ::: "memory"); } while (0)
#define RESC(a) do { if (__any((a) < 1.f)) { if (hi == 0) al_l[r32] = (a); asm volatile("s_waitcnt lgkmcnt(0)" ::: "memory"); \
    _Pragma("unroll") for (int d = 0; d < 4; ++d) _Pragma("unroll") for (int r = 0; r < 16; ++r) o[d][r] *= al_l[crow(r, hi)]; } } while (0)
  f32x16 pA0, pA1, pB0, pB1; float mnA, mnB, alA, alB; bf16x8 pa0, pa1, pa2, pa3; const int NT = seq / KVBLK;
  constexpr int SE = 0, SO = SDEPTH - 1;
  SLOAD(SE, 0); asm volatile("s_waitcnt vmcnt(0)" ::: "memory"); SWRITE(0, SE); __syncthreads();
  qkt(pA0, pA1, K_lds, qr, qrl, r32, hi); partialSM(pA0, pA1, m_reg, mnA, alA);
  SLOAD(SO, KVBLK); if constexpr (SDEPTH == 2) { if (2 < NT) SLOAD(SE, 2 * KVBLK); }
  SWAIT(); SWRITE(1, SO); __syncthreads();
  for (int j = 1; j + 1 < NT; j += 2) {
    SBAR(); qkt(pB0, pB1, K_lds + SHM_K, qr, qrl, r32, hi);
    finishSM(pA0, pA1, alA, l_reg, pa0, pa1, pa2, pa3); SBAR();
    SLOAD(SO, (j + SDEPTH) * KVBLK); SBAR();
    pv_d0(o, vb0, pa0, pa1, pa2, pa3); partialSM(pB0, pB1, m_reg, mnB, alB);
    __syncthreads(); SWAIT(); SWRITE(0, SE);
    RESC(alB); __syncthreads();
    SBAR(); qkt(pA0, pA1, K_lds, qr, qrl, r32, hi);
    finishSM(pB0, pB1, alB, l_reg, pa0, pa1, pa2, pa3); SBAR();
    if (SDEPTH == 1 || j + 3 < NT) SLOAD(SE, (j + 1 + SDEPTH) * KVBLK); SBAR();
    pv_d0(o, vb0 + (int)SHM_V, pa0, pa1, pa2, pa3); partialSM(pA0, pA1, m_reg, mnA, alA);
    __syncthreads(); SWAIT(); SWRITE(1, SO);
    RESC(alA); __syncthreads();
  }
  SBAR(); qkt(pB0, pB1, K_lds + SHM_K, qr, qrl, r32, hi);
  finishSM(pA0, pA1, alA, l_reg, pa0, pa1, pa2, pa3); SBAR();
  pv_d0(o, vb0, pa0, pa1, pa2, pa3); partialSM(pB0, pB1, m_reg, mnB, alB);
  __syncthreads(); RESC(alB);
  finishSM(pB0, pB1, alB, l_reg, pa0, pa1, pa2, pa3); SBAR();
  pv_d0(o, vb0 + (int)SHM_V, pa0, pa1, pa2, pa3);
  if (hi == 0) li_l[r32] = l_reg; asm volatile("s_waitcnt lgkmcnt(0)" ::: "memory");
  float rli[16];
#pragma unroll
  for (int r = 0; r < 16; ++r) rli[r] = __builtin_amdgcn_rcpf(li_l[crow(r, hi)]);
  bf16_t* Ow = Ob + (long)(wid * QBLK) * LDO;
#pragma unroll
  for (int r = 0; r < 16; ++r) { int orow = crow(r, hi);
#pragma unroll
    for (int d0 = 0; d0 < 4; ++d0) { const unsigned w = cvtpk(o[d0][r] * rli[r], 0.f); Ow[(long)orow * LDO + d0 * 32 + r32] = (bf16_t)(w & 0xffffu); } }
  __syncthreads();
#undef SLOAD
#undef SWRITE
#undef SWAIT
#undef RESC
}
#undef KSWZ
#undef SBAR
}
namespace gla {
typedef unsigned short bf16_t;
typedef short bf16x8 __attribute__((ext_vector_type(8)));
typedef float f32x4 __attribute__((ext_vector_type(4)));
typedef unsigned u32x4 __attribute__((ext_vector_type(4)));
typedef unsigned u32x2 __attribute__((ext_vector_type(2)));
constexpr int PQ = 272, PT = 144;
constexpr int L_QD = 0, L_KI = L_QD + 64 * PQ, L_SB = L_KI + 64 * PQ, L_KET = L_SB + 128 * PQ, L_VT = L_KET + 128 * PT, L_AT = L_VT + 128 * PT, L_DEC = L_AT + 64 * PT, L_END = L_DEC + 512;
constexpr int PROJ_LD = 5120;
typedef float f32x2_t __attribute__((ext_vector_type(2))); typedef __bf16 bf16x2_t __attribute__((ext_vector_type(2)));
__device__ __forceinline__ unsigned cvtpk(float lo, float hi) { f32x2_t v = {lo, hi}; bf16x2_t b = __builtin_convertvector(v, bf16x2_t); return __builtin_bit_cast(unsigned, b); }
__device__ __forceinline__ float bflo(unsigned w) { return __uint_as_float(w << 16); }
__device__ __forceinline__ float bfhi(unsigned w) { return __uint_as_float(w & 0xffff0000u); }
template <int CTRL, int ROWM> __device__ __forceinline__ float dpp0(float v) { return __int_as_float(__builtin_amdgcn_update_dpp(0, __float_as_int(v), CTRL, ROWM, 0xf, false)); }
template <int CTRL, int ROWM> __device__ __forceinline__ float dpp1(float v) { return __int_as_float(__builtin_amdgcn_update_dpp(0x3f800000, __float_as_int(v), CTRL, ROWM, 0xf, false)); }
#define GBAR() asm volatile("s_waitcnt lgkmcnt(0)\n\ts_barrier" ::: "memory")
#define MFMA16(a, b, c) __builtin_amdgcn_mfma_f32_16x16x32_bf16((a), (b), (c), 0, 0, 0)
#define LDSV(off) (*(const bf16x8*)(lds + (off)))

struct ChunkRegs { u32x4 q[2], f[2], v[2]; };
__device__ __forceinline__ void load_chunk(ChunkRegs& c, const bf16_t* __restrict__ PROJ, int b, int cc, int tl, size_t colq, size_t colf, size_t colv) {
  const bf16_t* rp = PROJ + ((size_t)b * 4096 + cc * 64 + tl) * PROJ_LD;
  c.q[0] = *(const u32x4*)(rp + colq); c.q[1] = *(const u32x4*)(rp + colq + 8); c.f[0] = *(const u32x4*)(rp + colf); c.f[1] = *(const u32x4*)(rp + colf + 8);
  c.v[0] = *(const u32x4*)(rp + colv); c.v[1] = *(const u32x4*)(rp + colv + 8);
}
__device__ __forceinline__ void scan_step(const ChunkRegs& c, f32x4 (&sacc)[8], const float (&lbk)[16], bf16_t* __restrict__ Odir, char* lds,
                                          int b, int h, int dir, int cc, int wid, int lane, int fr, int fq, int kbase) {
    float P[16], k0[16];
#pragma unroll
    for (int kk = 0; kk < 16; ++kk) { const unsigned w = c.f[kk >> 3][(kk & 7) >> 1]; const float x = (kk & 1) ? bfhi(w) : bflo(w);
      const float e = __expf(-x), sg = __builtin_amdgcn_rcpf(1.f + e); const float oml = 1.f - lbk[kk];
      P[kk] = lbk[kk] + oml * sg; k0[kk] = oml * (e * sg); }
#pragma unroll
    for (int kk = 0; kk < 16; ++kk) { float v = P[kk];
      v *= dpp1<0x111, 0xf>(v); v *= dpp1<0x112, 0xf>(v); v *= dpp1<0x114, 0xf>(v); v *= dpp1<0x118, 0xf>(v);
      v *= dpp1<0x142, 0xa>(v); v *= dpp1<0x143, 0xc>(v);
      P[kk] = v; }
    float qd[16], ki[16];
#pragma unroll
    for (int kk = 0; kk < 16; ++kk) { const float Pl = __int_as_float(__builtin_amdgcn_readlane(__float_as_int(P[kk]), 63));
      const unsigned wq = c.q[kk >> 3][(kk & 7) >> 1]; const float q = (kk & 1) ? bfhi(wq) : bflo(wq);
      const unsigned wv = c.v[kk >> 3][(kk & 7) >> 1]; const float v = (kk & 1) ? bfhi(wv) : bflo(wv);
      qd[kk] = q * 0.08838834764831845f * P[kk]; ki[kk] = k0[kk] * __builtin_amdgcn_rcpf(P[kk]);
      const float ke = ki[kk] * Pl;
      *(bf16_t*)(lds + L_KET + (kbase + kk) * PT + lane * 2) = (bf16_t)(cvtpk(ke, 0.f) & 0xffffu);
      *(bf16_t*)(lds + L_VT + (kbase + kk) * PT + lane * 2) = (bf16_t)(cvtpk(v, 0.f) & 0xffffu); }
    if (lane == 63) {
#pragma unroll
      for (int g4 = 0; g4 < 4; ++g4) *(f32x4*)(lds + L_DEC + (kbase + 4 * g4) * 4) = (f32x4){P[4 * g4], P[4 * g4 + 1], P[4 * g4 + 2], P[4 * g4 + 3]}; }
#pragma unroll
    for (int g8 = 0; g8 < 2; ++g8) {
      u32x4 w; w.x = cvtpk(qd[8 * g8 + 0], qd[8 * g8 + 1]); w.y = cvtpk(qd[8 * g8 + 2], qd[8 * g8 + 3]); w.z = cvtpk(qd[8 * g8 + 4], qd[8 * g8 + 5]); w.w = cvtpk(qd[8 * g8 + 6], qd[8 * g8 + 7]);
      *(u32x4*)(lds + L_QD + lane * PQ + (kbase + 8 * g8) * 2) = w;
      u32x4 z; z.x = cvtpk(ki[8 * g8 + 0], ki[8 * g8 + 1]); z.y = cvtpk(ki[8 * g8 + 2], ki[8 * g8 + 3]); z.z = cvtpk(ki[8 * g8 + 4], ki[8 * g8 + 5]); z.w = cvtpk(ki[8 * g8 + 6], ki[8 * g8 + 7]);
      *(u32x4*)(lds + L_KI + lane * PQ + (kbase + 8 * g8) * 2) = z;
    }
    GBAR();
#pragma unroll
    for (int q2 = 0; q2 < 2; ++q2) { const int id = 2 * wid + q2, jt = id >> 2, it = id & 3;
      f32x4 cacc = (f32x4){0.f, 0.f, 0.f, 0.f};
      if (jt <= it) {
#pragma unroll
        for (int ks = 0; ks < 4; ++ks) { const bf16x8 a = LDSV(L_KI + (16 * jt + fr) * PQ + (32 * ks + 8 * fq) * 2); const bf16x8 bq = LDSV(L_QD + (16 * it + fr) * PQ + (32 * ks + 8 * fq) * 2); cacc = MFMA16(a, bq, cacc); }
      }
      const int i = 16 * it + fr, j0 = 16 * jt + 4 * fq;
      const float c0 = (j0 + 0 <= i) ? cacc[0] : 0.f, c1 = (j0 + 1 <= i) ? cacc[1] : 0.f, c2 = (j0 + 2 <= i) ? cacc[2] : 0.f, c3 = (j0 + 3 <= i) ? cacc[3] : 0.f;
      u32x2 w; w.x = cvtpk(c0, c1); w.y = cvtpk(c2, c3);
      *(u32x2*)(lds + L_AT + i * PT + j0 * 2) = w; }
    { const bf16x8 a0 = LDSV(L_KET + (kbase + fr) * PT + (8 * fq) * 2), a1 = LDSV(L_KET + (kbase + fr) * PT + (32 + 8 * fq) * 2);
      const f32x4 d4 = *(const f32x4*)(lds + L_DEC + (kbase + 4 * fq) * 4);
#pragma unroll
      for (int n = 0; n < 8; ++n) { const bf16x8 b0 = LDSV(L_VT + (16 * n + fr) * PT + (8 * fq) * 2), b1 = LDSV(L_VT + (16 * n + fr) * PT + (32 + 8 * fq) * 2);
        f32x4 t = sacc[n] * d4; t = MFMA16(a0, b0, t); sacc[n] = MFMA16(a1, b1, t); } }
    GBAR();
    { bf16x8 av[2], as[4];
#pragma unroll
      for (int ks = 0; ks < 2; ++ks) av[ks] = LDSV(L_VT + (kbase + fr) * PT + (32 * ks + 8 * fq) * 2);
#pragma unroll
      for (int ks = 0; ks < 4; ++ks) as[ks] = LDSV(L_SB + (kbase + fr) * PQ + (32 * ks + 8 * fq) * 2);
#pragma unroll
      for (int tt = 0; tt < 4; ++tt) { f32x4 cacc = (f32x4){0.f, 0.f, 0.f, 0.f};
#pragma unroll
        for (int ks = 0; ks < 2; ++ks) cacc = MFMA16(av[ks], LDSV(L_AT + (16 * tt + fr) * PT + (32 * ks + 8 * fq) * 2), cacc);
#pragma unroll
        for (int ks = 0; ks < 4; ++ks) cacc = MFMA16(as[ks], LDSV(L_QD + (16 * tt + fr) * PQ + (32 * ks + 8 * fq) * 2), cacc);
        const int t = 16 * tt + fr, tg = dir ? 63 - t : t;
        u32x2 w; w.x = cvtpk(cacc[0], cacc[1]); w.y = cvtpk(cacc[2], cacc[3]);
        *(u32x2*)(Odir + ((size_t)b * 4096 + cc * 64 + tg) * 1024 + h * 128 + kbase + 4 * fq) = w; } }
    GBAR();
#pragma unroll
    for (int n = 0; n < 8; ++n) { u32x2 w; w.x = cvtpk(sacc[n][0], sacc[n][1]); w.y = cvtpk(sacc[n][2], sacc[n][3]);
      *(u32x2*)(lds + L_SB + (16 * n + fr) * PQ + (kbase + 4 * fq) * 2) = w; }
}

__device__ __forceinline__ void scan_chain(const bf16_t* __restrict__ PROJ, const float* __restrict__ lbv, bf16_t* __restrict__ OF, bf16_t* __restrict__ OB, int chain, char* lds) {
  const int tid = threadIdx.x, wid = __builtin_amdgcn_readfirstlane(tid >> 6), lane = tid & 63, fr = lane & 15, fq = lane >> 4;
  const int dir = chain & 1, h = (chain >> 1) & 7, b = chain >> 4;
  bf16_t* Odir = dir ? OB : OF;
  const int kbase = 16 * wid;
  float lbk[16];
#pragma unroll
  for (int kk = 0; kk < 16; ++kk) lbk[kk] = lbv[h * 128 + kbase + kk];
  for (int i = tid; i < (128 * PQ) / 16; i += 512) *(u32x4*)(lds + L_SB + i * 16) = (u32x4){0u, 0u, 0u, 0u};
  f32x4 sacc[8];
#pragma unroll
  for (int n = 0; n < 8; ++n) sacc[n] = (f32x4){0.f, 0.f, 0.f, 0.f};
  const int tl = dir ? 63 - lane : lane;
  const size_t colq = (size_t)h * 128 + kbase, colf = 1024 + (size_t)dir * 1024 + colq, colv = 3072 + colq;
  ChunkRegs A, B;
  load_chunk(A, PROJ, b, dir ? 63 : 0, tl, colq, colf, colv);
  __syncthreads();
  for (int s = 0; s < 64; s += 2) {
    { const int cn = dir ? 62 - s : s + 1; load_chunk(B, PROJ, b, cn, tl, colq, colf, colv); }
    scan_step(A, sacc, lbk, Odir, lds, b, h, dir, dir ? 63 - s : s, wid, lane, fr, fq, kbase);
    if (s + 2 < 64) { const int cn = dir ? 61 - s : s + 2; load_chunk(A, PROJ, b, cn, tl, colq, colf, colv); }
    scan_step(B, sacc, lbk, Odir, lds, b, h, dir, dir ? 62 - s : s + 1, wid, lane, fr, fq, kbase);
  }
  __syncthreads();
}
#undef GBAR
#undef MFMA16
#undef LDSV
}
#define LAS __attribute__((address_space(3)))
#define XB_TMO      128
#define XB_XCNT(j)  (256  + 64 * (j))
#define XB_XSUB(j)  (1280 + 64 * (j))
#define XB_XGEN(j)  (2304 + 64 * (j))
#define XB_TOP      3328
#define XB_TOPGEN   3392
#define XCD_BAR_WORDS 3456
#define XB_SPIN_CAP (1u << 18)

__device__ __forceinline__ unsigned xb_ld(unsigned* p)              { return __hip_atomic_load(p, __ATOMIC_RELAXED, __HIP_MEMORY_SCOPE_AGENT); }
__device__ __forceinline__ unsigned xb_add(unsigned* p, unsigned v) { return __hip_atomic_fetch_add(p, v, __ATOMIC_RELAXED, __HIP_MEMORY_SCOPE_AGENT); }
__device__ __forceinline__ unsigned xb_xcc_id() { return (unsigned)__builtin_amdgcn_s_getreg((3 << 11) | 20) & 0xFu; }
#define XB_SPIN(cond, bar) do { unsigned _sp = 0; while (cond) { __builtin_amdgcn_s_sleep(1); \
    if ((++_sp & 255u) == 0u) { if (xb_ld(&(bar)[XB_TMO])) break; if (_sp > XB_SPIN_CAP) { atomicAdd(&(bar)[XB_TMO], 1u); break; } } } } while (0)

struct XcdBarrier {
    unsigned* bar; unsigned x;
    volatile LAS unsigned* st;
};

__device__ __forceinline__ XcdBarrier xcd_barrier_post(unsigned* bar, volatile LAS unsigned* st) {
    XcdBarrier b; b.bar = bar; b.x = xb_xcc_id(); b.st = st;
    if (threadIdx.x == 0) (void)xb_add(&bar[XB_XCNT(b.x)], 1u);
    return b;
}
__device__ __forceinline__ void xcd_barrier_complete(unsigned* bar, unsigned x, unsigned& nloc, unsigned& nx) {
    const unsigned G = gridDim.x * gridDim.y * gridDim.z;
    unsigned sum, cnt, mine, sp = 0u;
    for (;;) {
        sum = 0u; cnt = 0u; mine = 0u;
#pragma unroll
        for (unsigned j = 0; j < 16; ++j) { const unsigned c = xb_ld(&bar[XB_XCNT(j)]); sum += c; cnt += (c > 0u) ? 1u : 0u; mine = (j == x) ? c : mine; }
        if (sum == G) break;
        __builtin_amdgcn_s_sleep(1);
        if ((++sp & 255u) == 0u) { if (xb_ld(&bar[XB_TMO])) break; if (sp > XB_SPIN_CAP) { atomicAdd(&bar[XB_TMO], 1u); break; } }
    }
    nloc = mine > 0u ? mine : 1u; nx = cnt > 0u ? cnt : 1u;
}

__device__ __forceinline__ void xcd_barrier(const XcdBarrier& b) {
    asm volatile("s_waitcnt vmcnt(0)" ::: "memory");
    __syncthreads();
    if (threadIdx.x == 0) {
        unsigned* bar = b.bar;
        __builtin_amdgcn_s_waitcnt(0);
        unsigned nloc = b.st[0], nx = b.st[1];
        if (nloc == 0u) { xcd_barrier_complete(bar, b.x, nloc, nx); b.st[0] = nloc; b.st[1] = nx; }
        const unsigned old = xb_add(&bar[XB_XSUB(b.x)], 1u);
        const unsigned gen = old / nloc;
        if (old + 1u == (gen + 1u) * nloc) {
            __builtin_amdgcn_fence(__ATOMIC_RELEASE, "agent");
            asm volatile("s_waitcnt vmcnt(0)" ::: "memory");
            const unsigned og = xb_add(&bar[XB_TOP], 1u);
            const unsigned tg = og / nx;
            if (og + 1u == (tg + 1u) * nx) xb_add(&bar[XB_TOPGEN], 1u);
            else XB_SPIN(xb_ld(&bar[XB_TOPGEN]) == tg, bar);
            __builtin_amdgcn_fence(__ATOMIC_ACQUIRE, "agent");
            xb_add(&bar[XB_XGEN(b.x)], 1u);
            asm volatile("s_waitcnt vmcnt(0)" ::: "memory");
        } else {
            XB_SPIN(xb_ld(&bar[XB_XGEN(b.x)]) == gen, bar);
            __builtin_amdgcn_fence(__ATOMIC_ACQUIRE, "agent");
            asm volatile("s_waitcnt vmcnt(0)" ::: "memory");
        }
    }
    __syncthreads();
}
typedef unsigned short bf16_t;
typedef float f32x4 __attribute__((ext_vector_type(4)));
typedef unsigned u32x4 __attribute__((ext_vector_type(4)));
typedef unsigned u32x2 __attribute__((ext_vector_type(2)));
constexpr int NT_ = 65536, DM = 1024, SEQ = 4096, NB = 16, DFF = 4096;
constexpr float EPS = 1e-6f;
constexpr size_t MiB = 1u << 20;
constexpr size_t W_HGIN = 0, W_HGOUT = W_HGIN + 10 * MiB, W_UP = W_HGOUT + 2 * MiB  , W_DN = W_UP + 16 * MiB  , W_PP = W_DN + 16 * MiB  ,
                 W_PG = W_PP + 1 * MiB  , W_MLAIN = W_PG + 4 * MiB  , W_UQ = W_MLAIN + 1536 * 1024  , W_UKV = W_UQ + 2304 * 1024  , W_O = W_UKV + 2 * MiB  , W_END = W_O + 4 * MiB;
static_assert(W_END <= 59 * MiB, "weights");
constexpr size_t WS_PART = 59 * MiB, WS_LB = 63 * MiB, WS_P16 = 64 * MiB, WS_BIG0 = 96 * MiB, WS_HID = 224 * MiB, WS_A = 736 * MiB, WS_B = 864 * MiB, WS_CS = 992 * MiB;
constexpr size_t WS_CQ = 96 * MiB, WS_CKV = 144 * MiB, WS_KR = 176 * MiB, WS_QH = 192 * MiB, WS_KVH = 384 * MiB, WS_M3 = 384 * MiB;
constexpr size_t WS_NEED = 1008 * MiB;
constexpr size_t WS_RS = 63 * MiB + 64 * 1024;
constexpr int LDS_BYTES = 135168;
constexpr int XB_LDS_OFF = 131072 + 256;
constexpr size_t WS_CTL = 63 * MiB + 512 * 1024, CTL_BYTES = 16384;

typedef float f32x2_t __attribute__((ext_vector_type(2))); typedef __bf16 bf16x2_t __attribute__((ext_vector_type(2)));
__device__ __forceinline__ unsigned pk2(float lo, float hi) { f32x2_t v = {lo, hi}; bf16x2_t b = __builtin_convertvector(v, bf16x2_t); return __builtin_bit_cast(unsigned, b); }
__device__ __forceinline__ float wave_sum(float v) {
#pragma unroll
  for (int o = 1; o < 64; o <<= 1) v += __shfl_xor(v, o);
  return v;
}
__device__ __forceinline__ void transpose_item(const float* __restrict__ W, int K, int N, bf16_t* __restrict__ WT, float* scr, int item, int lane, const float* __restrict__ gk = nullptr) {
  const int nblk = N / 32, kb = item / nblk, nb = item % nblk, k0 = 64 * kb, n0 = 32 * nb;
  float wv[32];
#pragma unroll
  for (int i = 0; i < 32; ++i) { const int kk = 2 * i + (lane >> 5); wv[i] = W[(size_t)(k0 + kk) * N + n0 + (lane & 31)]; }
#pragma unroll
  for (int i = 0; i < 32; ++i) { const int kk = 2 * i + (lane >> 5); scr[kk * 33 + (lane & 31)] = gk ? wv[i] * gk[k0 + kk] : wv[i]; }
  asm volatile("s_waitcnt lgkmcnt(0)" ::: "memory");
  const int c = lane & 7;
#pragma unroll
  for (int j = 0; j < 4; ++j) { const int n = (lane >> 3) + 8 * j; const float* s = scr + (8 * c) * 33 + n;
    u32x4 o; o.x = pk2(s[0 * 33], s[1 * 33]); o.y = pk2(s[2 * 33], s[3 * 33]); o.z = pk2(s[4 * 33], s[5 * 33]); o.w = pk2(s[6 * 33], s[7 * 33]);
    *(u32x4*)(WT + (size_t)(n0 + n) * K + k0 + 8 * c) = o; }
  asm volatile("s_waitcnt lgkmcnt(0)" ::: "memory");
}

struct Args { const float* in[22]; float* out; unsigned char* ws; int ph_lo, ph_hi; };

struct RowOp { float* rsout; const bf16_t* hin16; bf16_t* hout16; const float* hin; const bf16_t* m; const float* part; const float* gpost; float* hout; bf16_t* aout; const float* gnext; const float* pin; bf16_t* p16; };
constexpr int RB = 4;
__device__ __forceinline__ void row_phase(const RowOp& r, int gw, int ngw, int lane) {
  for (int row0 = gw * RB; row0 < NT_; row0 += ngw * RB) {
    f32x4 v[RB][4]; u32x2 mm[RB][4]; float pp[RB];
    if (r.hin16) {
#pragma unroll
      for (int b = 0; b < RB; ++b) { const bf16_t* hr = r.hin16 + (size_t)(row0 + b) * DM + 4 * lane;
#pragma unroll
        for (int j = 0; j < 4; ++j) { const u32x2 hh = *(const u32x2*)(hr + 256 * j); v[b][j] = (f32x4){__uint_as_float(hh.x << 16), __uint_as_float(hh.x & 0xffff0000u), __uint_as_float(hh.y << 16), __uint_as_float(hh.y & 0xffff0000u)}; } }
    } else {
#pragma unroll
      for (int b = 0; b < RB; ++b) { const float* hr = r.hin + (size_t)(row0 + b) * DM + 4 * lane;
#pragma unroll
        for (int j = 0; j < 4; ++j) v[b][j] = *(const f32x4*)(hr + 256 * j); }
    }
    if (r.m) {
#pragma unroll
      for (int b = 0; b < RB; ++b) { pp[b] = r.part[(size_t)(row0 + b) * 16 + (lane & 15)]; const bf16_t* mr = r.m + (size_t)(row0 + b) * DM + 4 * lane;
#pragma unroll
        for (int j = 0; j < 4; ++j) mm[b][j] = *(const u32x2*)(mr + 256 * j); }
      f32x4 g[4];
#pragma unroll
      for (int j = 0; j < 4; ++j) g[j] = *(const f32x4*)(r.gpost + 4 * lane + 256 * j);
#pragma unroll
      for (int b = 0; b < RB; ++b) { float p_ = pp[b]; p_ += __shfl_xor(p_, 1); p_ += __shfl_xor(p_, 2); p_ += __shfl_xor(p_, 4); p_ += __shfl_xor(p_, 8);
        const float rs = rsqrtf(p_ * (1.f / DM) + EPS);
#pragma unroll
        for (int j = 0; j < 4; ++j) { const u32x2 m2 = mm[b][j];
          v[b][j][0] += __uint_as_float(m2.x << 16) * rs * g[j][0]; v[b][j][1] += __uint_as_float(m2.x & 0xffff0000u) * rs * g[j][1];
          v[b][j][2] += __uint_as_float(m2.y << 16) * rs * g[j][2]; v[b][j][3] += __uint_as_float(m2.y & 0xffff0000u) * rs * g[j][3]; } }
    }
    if (r.hout) {
#pragma unroll
      for (int b = 0; b < RB; ++b) { float* ho = r.hout + (size_t)(row0 + b) * DM + 4 * lane;
#pragma unroll
        for (int j = 0; j < 4; ++j) *(f32x4*)(ho + 256 * j) = v[b][j]; } }
    if (r.hout16) {
#pragma unroll
      for (int b = 0; b < RB; ++b) { bf16_t* ho = r.hout16 + (size_t)(row0 + b) * DM + 4 * lane;
#pragma unroll
        for (int j = 0; j < 4; ++j) { u32x2 w; w.x = pk2(v[b][j][0], v[b][j][1]); w.y = pk2(v[b][j][2], v[b][j][3]); *(u32x2*)(ho + 256 * j) = w; } } }
    if (r.rsout) {
      float ss[RB];
#pragma unroll
      for (int b = 0; b < RB; ++b) { ss[b] = 0.f;
#pragma unroll
        for (int j = 0; j < 4; ++j) ss[b] += (v[b][j][0] * v[b][j][0] + v[b][j][1] * v[b][j][1]) + (v[b][j][2] * v[b][j][2] + v[b][j][3] * v[b][j][3]); }
#pragma unroll
      for (int o = 1; o < 64; o <<= 1) {
#pragma unroll
        for (int b = 0; b < RB; ++b) ss[b] += __shfl_xor(ss[b], o); }
      if (lane < RB) { float sel = ss[0];
#pragma unroll
        for (int b = 1; b < RB; ++b) sel = (lane == b) ? ss[b] : sel;
        r.rsout[row0 + lane] = rsqrtf(sel * (1.f / DM) + EPS); }
    }
    if (r.aout) {
      if (r.gnext) {
        f32x4 g[4];
#pragma unroll
        for (int j = 0; j < 4; ++j) g[j] = *(const f32x4*)(r.gnext + 4 * lane + 256 * j);
        float ss[RB];
#pragma unroll
        for (int b = 0; b < RB; ++b) { ss[b] = 0.f;
#pragma unroll
          for (int j = 0; j < 4; ++j) ss[b] += (v[b][j][0] * v[b][j][0] + v[b][j][1] * v[b][j][1]) + (v[b][j][2] * v[b][j][2] + v[b][j][3] * v[b][j][3]); }
#pragma unroll
        for (int o = 1; o < 64; o <<= 1) {
#pragma unroll
          for (int b = 0; b < RB; ++b) ss[b] += __shfl_xor(ss[b], o); }
#pragma unroll
        for (int b = 0; b < RB; ++b) { const float rs2 = rsqrtf(ss[b] * (1.f / DM) + EPS); bf16_t* ao = r.aout + (size_t)(row0 + b) * DM + 4 * lane;
#pragma unroll
          for (int j = 0; j < 4; ++j) { u32x2 w; w.x = pk2(v[b][j][0] * rs2 * g[j][0], v[b][j][1] * rs2 * g[j][1]); w.y = pk2(v[b][j][2] * rs2 * g[j][2], v[b][j][3] * rs2 * g[j][3]); *(u32x2*)(ao + 256 * j) = w; } }
      } else {
#pragma unroll
        for (int b = 0; b < RB; ++b) { bf16_t* ao = r.aout + (size_t)(row0 + b) * DM + 4 * lane;
#pragma unroll
          for (int j = 0; j < 4; ++j) { u32x2 w; w.x = pk2(v[b][j][0], v[b][j][1]); w.y = pk2(v[b][j][2], v[b][j][3]); *(u32x2*)(ao + 256 * j) = w; } }
      }
    }
    if (r.pin) {
#pragma unroll
      for (int b = 0; b < RB; ++b) { const f32x4 pv = *(const f32x4*)(r.pin + (size_t)(row0 + b) * 256 + 4 * lane); u32x2 w; w.x = pk2(pv[0], pv[1]); w.y = pk2(pv[2], pv[3]); *(u32x2*)(r.p16 + (size_t)(row0 + b) * 256 + 4 * lane) = w; } }
  }
}

__device__ __forceinline__ float bf_lo(unsigned w) { return __uint_as_float(w << 16); }
__device__ __forceinline__ float bf_hi(unsigned w) { return __uint_as_float(w & 0xffff0000u); }

__device__ __forceinline__ void comb_phase(bf16_t* OF, const bf16_t* OB, const bf16_t* PROJ, const float* onorm, int gw, int ngw, int lane) {
  constexpr int CB = 2;
  float on[16];
#pragma unroll
  for (int i = 0; i < 16; ++i) on[i] = onorm[16 * lane + i];
  for (int row0 = gw * CB; row0 < NT_; row0 += ngw * CB) {
    u32x4 a[CB][2], bb[CB][2], gg[CB][2];
#pragma unroll
    for (int b = 0; b < CB; ++b) { const bf16_t* of = OF + (size_t)(row0 + b) * DM + 16 * lane; const bf16_t* ob = OB + (size_t)(row0 + b) * DM + 16 * lane; const bf16_t* gt = PROJ + (size_t)(row0 + b) * 5120 + 4096 + 16 * lane;
#pragma unroll
      for (int q = 0; q < 2; ++q) { a[b][q] = *(const u32x4*)(of + 8 * q); bb[b][q] = *(const u32x4*)(ob + 8 * q); gg[b][q] = *(const u32x4*)(gt + 8 * q); } }
#pragma unroll
    for (int b = 0; b < CB; ++b) {
      float s[16], g[16];
#pragma unroll
      for (int q = 0; q < 2; ++q)
#pragma unroll
        for (int i = 0; i < 4; ++i) { s[8 * q + 2 * i] = bf_lo(a[b][q][i]) + bf_lo(bb[b][q][i]); s[8 * q + 2 * i + 1] = bf_hi(a[b][q][i]) + bf_hi(bb[b][q][i]); g[8 * q + 2 * i] = bf_lo(gg[b][q][i]); g[8 * q + 2 * i + 1] = bf_hi(gg[b][q][i]); }
      float ss = 0.f;
#pragma unroll
      for (int i = 0; i < 16; ++i) ss += s[i] * s[i];
      ss += __shfl_xor(ss, 1); ss += __shfl_xor(ss, 2); ss += __shfl_xor(ss, 4);
      const float rs = rsqrtf(ss * (1.f / 128.f) + EPS);
      float o[16];
#pragma unroll
      for (int i = 0; i < 16; ++i) { const float gv = g[i]; o[i] = s[i] * rs * on[i] * (gv * __builtin_amdgcn_rcpf(1.f + __expf(-gv))); }
      bf16_t* of = OF + (size_t)(row0 + b) * DM + 16 * lane;
#pragma unroll
      for (int q = 0; q < 2; ++q) { u32x4 w; w.x = pk2(o[8 * q], o[8 * q + 1]); w.y = pk2(o[8 * q + 2], o[8 * q + 3]); w.z = pk2(o[8 * q + 4], o[8 * q + 5]); w.w = pk2(o[8 * q + 6], o[8 * q + 7]); *(u32x4*)(of + 8 * q) = w; }
    }
  }
}

__device__ __forceinline__ void rn_phase(const bf16_t* PRJ, const float* qn, const float* kvn, const float2* CS, bf16_t* CQ, bf16_t* CKV, bf16_t* KR, int gw, int ngw, int lane) {
  constexpr int NB = 4;
  float gq[6], gk[4];
#pragma unroll
  for (int j = 0; j < 3; ++j) { gq[2 * j] = qn[2 * lane + 128 * j]; gq[2 * j + 1] = qn[2 * lane + 128 * j + 1]; }
#pragma unroll
  for (int j = 0; j < 2; ++j) { gk[2 * j] = kvn[2 * lane + 128 * j]; gk[2 * j + 1] = kvn[2 * lane + 128 * j + 1]; }
  for (int row0 = gw * NB; row0 < NT_; row0 += ngw * NB) {
    unsigned wq[NB][3], wk[NB][2], wr[NB]; f32x4 cs[NB];
#pragma unroll
    for (int b = 0; b < NB; ++b) { const unsigned* pr = (const unsigned*)(PRJ + (size_t)(row0 + b) * 768);
#pragma unroll
      for (int j = 0; j < 3; ++j) wq[b][j] = pr[lane + 64 * j];
#pragma unroll
      for (int j = 0; j < 2; ++j) wk[b][j] = pr[192 + lane + 64 * j];
      wr[b] = pr[320 + (lane & 31)];
      cs[b] = *(const f32x4*)(CS + (size_t)(row0 + b) * 32 + 2 * (lane & 15)); }
#pragma unroll
    for (int b = 0; b < NB; ++b) {
      float q[6], c[4]; float sq = 0.f, sc = 0.f;
#pragma unroll
      for (int j = 0; j < 3; ++j) { q[2 * j] = bf_lo(wq[b][j]); q[2 * j + 1] = bf_hi(wq[b][j]); sq += q[2 * j] * q[2 * j] + q[2 * j + 1] * q[2 * j + 1]; }
#pragma unroll
      for (int j = 0; j < 2; ++j) { c[2 * j] = bf_lo(wk[b][j]); c[2 * j + 1] = bf_hi(wk[b][j]); sc += c[2 * j] * c[2 * j] + c[2 * j + 1] * c[2 * j + 1]; }
      const float rq = rsqrtf(wave_sum(sq) * (1.f / 384.f) + EPS), rc = rsqrtf(wave_sum(sc) * (1.f / 256.f) + EPS);
      unsigned* oq = (unsigned*)(CQ + (size_t)(row0 + b) * 384); unsigned* ok = (unsigned*)(CKV + (size_t)(row0 + b) * 256);
#pragma unroll
      for (int j = 0; j < 3; ++j) oq[lane + 64 * j] = pk2(q[2 * j] * rq * gq[2 * j], q[2 * j + 1] * rq * gq[2 * j + 1]);
#pragma unroll
      for (int j = 0; j < 2; ++j) ok[lane + 64 * j] = pk2(c[2 * j] * rc * gk[2 * j], c[2 * j + 1] * rc * gk[2 * j + 1]);
      const float k0 = bf_lo(wr[b]), k1 = bf_hi(wr[b]);
      const float p0 = __shfl_xor(k0, 16), p1 = __shfl_xor(k1, 16);
      const bool lo16 = (lane & 16) == 0;
      const float r0 = lo16 ? (k0 * cs[b][0] - p0 * cs[b][1]) : (p0 * cs[b][1] + k0 * cs[b][0]);
      const float r1 = lo16 ? (k1 * cs[b][2] - p1 * cs[b][3]) : (p1 * cs[b][3] + k1 * cs[b][2]);
      if (lane < 32) ((unsigned*)(KR + (size_t)(row0 + b) * 64))[lane] = pk2(r0, r1);
    }
  }
}

enum { OP_P0 = 0, OP_GEMM, OP_SCAN, OP_COMB, OP_ROW, OP_RN, OP_ATT };
constexpr int N_OPS = 28;
__device__ __forceinline__ int op_kind(int i) {
  switch (i) { case 0: return OP_P0; case 2: return OP_SCAN; case 3: return OP_COMB; case 13: return OP_RN; case 16: case 19: return OP_ATT;
    case 5: case 9: case 11: case 21: case 25: case 27: return OP_ROW; default: return OP_GEMM; }
}
__device__ __forceinline__ bool op_sync(int i) { return !(i == 7 || i == 14 || i == 17 || i == 23); }
#define WSB(off) ((bf16_t*)(ws + (off)))

#ifndef SCAN_REPS
#define SCAN_REPS 1
#endif
#ifndef GEMM_REPS
#define GEMM_REPS 1
#endif
template <int M, int N, int K, int MODE>
__device__ __forceinline__ void gemm_t(const bf16_t* A, const bf16_t* Bt, bf16_t* O, const bf16_t* E, float* part, unsigned char* lds) {
  pg8::Gemm g{A, Bt, M, N, K}; pg8::StaticOrder S; S.init(M, N, (int)gridDim.x, (int)blockIdx.x);
  pg8::EpiGen<MODE> Ep{O, N, part, E};
  pg8::gemm_phase<pg8::EpiGen<MODE>, pg8::StaticOrder, true, true>((PG8_LAS unsigned char*)lds, g, S, Ep);
  __syncthreads();
#if GEMM_REPS == 2
  pg8::gemm_phase<pg8::EpiGen<MODE>, pg8::StaticOrder, true, true>((PG8_LAS unsigned char*)lds, g, S, Ep);
  __syncthreads();
#endif
}
__device__ __forceinline__ void do_row(const Args& args, int opi, int gw, int ngw, int lane) {
  unsigned char* ws = args.ws; bf16_t* H16 = (bf16_t*)args.out;
  RowOp r; r.rsout = nullptr; r.hin16 = H16; r.hout16 = H16; r.hin = nullptr; r.m = WSB(WS_B); r.part = (const float*)(ws + WS_PART); r.gpost = nullptr; r.hout = nullptr; r.aout = nullptr; r.gnext = nullptr; r.pin = nullptr; r.p16 = WSB(WS_P16);
  switch (opi) {
    case 5: r.hin16 = nullptr; r.hin = args.in[0]; r.gpost = args.in[4]; r.rsout = (float*)(ws + WS_RS); r.pin = args.in[1]; break;
    case 9: r.gpost = args.in[6]; break;
    case 11: r.gpost = args.in[11]; r.rsout = (float*)(ws + WS_RS); break;
    case 21: r.m = WSB(WS_M3); r.gpost = args.in[4] + DM; r.rsout = (float*)(ws + WS_RS); r.pin = args.in[1] + (size_t)NT_ * 256; break;
    case 25: r.gpost = args.in[6] + DM; r.hout16 = WSB(WS_BIG0); break;
    default: r.hin16 = WSB(WS_BIG0); r.hout16 = nullptr; r.hout = args.out; r.gpost = args.in[11] + DM; break;
  }
  row_phase(r, gw, ngw, lane);
}

__device__ __forceinline__ void do_att(const Args& args, int half, int vcu, unsigned char* lds) {
  unsigned char* ws = args.ws; const float2* CS = (const float2*)(ws + WS_CS); const int G = gridDim.x;
  for (int u = vcu; u < 2048; u += G) {
    const int bh = u >> 4, qb = u & 15, bl = bh >> 4, h = bh & 15; const int bglob = half * 8 + bl;
    att::attn_unit(WSB(WS_QH) + ((size_t)bl * SEQ + qb * 256) * 3072 + h * 192, WSB(WS_KVH) + (size_t)bl * SEQ * 4096 + h * 256, WSB(WS_KR) + (size_t)bglob * SEQ * 64,
                   CS + ((size_t)bglob * SEQ + qb * 256) * 32, WSB(WS_A) + ((size_t)bglob * SEQ + qb * 256) * 2048 + h * 128, SEQ, (char*)lds);
  }
}

__device__ __forceinline__ void do_p0(const Args& args, int gw, int ngw, int lane, int wave, unsigned char* lds) {
  unsigned char* ws = args.ws;
  float* scr = (float*)lds + wave * (64 * 33);
  int base = 0;
#define TRG(SRC, KK, NN, DST, GK) do { const int items = ((KK) / 64) * ((NN) / 32); int first = (gw - base) % ngw; if (first < 0) first += ngw; \
    for (int it = first; it < items; it += ngw) transpose_item((SRC), (KK), (NN), WSB(DST), scr, it, lane, (GK)); base += items; } while (0)
#define TR(SRC, KK, NN, DST) TRG(SRC, KK, NN, DST, nullptr)
  TR(args.in[13], 1024, 5120, W_HGIN); TR(args.in[15], 1024, 1024, W_HGOUT);
  TRG(args.in[7], 1024, 4096, W_UP, args.in[5]); TRG(args.in[7] + (size_t)DM * DFF, 1024, 4096, W_UP + 8 * MiB, args.in[5] + DM);
  TR(args.in[8], 4096, 1024, W_DN); TR(args.in[8] + (size_t)DM * DFF, 4096, 1024, W_DN + 8 * MiB);
  TR(args.in[9], 256, 1024, W_PP); TR(args.in[9] + 256 * DM, 256, 1024, W_PP + 512 * 1024);
  TR(args.in[10], 1024, 1024, W_PG); TR(args.in[10] + (size_t)DM * DM, 1024, 1024, W_PG + 2 * MiB);
  TRG(args.in[16], 1024, 704, W_MLAIN, args.in[3] + DM); TR(args.in[18], 384, 3072, W_UQ); TR(args.in[20], 256, 4096, W_UKV); TR(args.in[21], 2048, 1024, W_O);
#undef TR
#undef TRG
  for (int i = gw * 64 + lane; i < 64 * 1024 / 8; i += ngw * 64) *(u32x4*)(WSB(W_MLAIN) + (size_t)704 * 1024 + (size_t)i * 8) = (u32x4){0u, 0u, 0u, 0u};
  if (blockIdx.x == 0) { float* lbv = (float*)(ws + WS_LB); for (int c = threadIdx.x; c < 1024; c += 512) { const float* L = args.in[12]; const float l0 = L[c], l1 = L[1024 + c], l2 = L[2048 + c]; const float mx = fmaxf(l0, fmaxf(l1, l2));
      const float e0 = __expf(l0 - mx), e1 = __expf(l1 - mx), e2 = __expf(l2 - mx); lbv[c] = e0 / (e0 + e1 + e2); } }
  { float2* CS = (float2*)(ws + WS_CS); const int* positions = (const int*)args.in[2];
    for (int i = gw * 64 + lane; i < NT_ * 32; i += ngw * 64) { const int row = i >> 5, fi = i & 31;
      const float inv = 1.0f / exp2f((float)fi * (13.287712379549449f / 32.f)); const float ang = (float)positions[row] * inv;
      double rev = (double)ang * 0.15915494309189535; rev -= floor(rev); const float rf = (float)rev;
      CS[i] = make_float2(__builtin_amdgcn_cosf(rf), __builtin_amdgcn_sinf(rf)); } }
  RowOp r0; r0.rsout = nullptr; r0.hin16 = nullptr; r0.hout16 = nullptr; r0.hin = args.in[0]; r0.m = nullptr; r0.part = nullptr; r0.gpost = nullptr; r0.hout = nullptr; r0.aout = WSB(WS_A); r0.gnext = args.in[3]; r0.pin = nullptr; r0.p16 = nullptr;
  row_phase(r0, gw, ngw, lane);
}

__global__ void __launch_bounds__(512, 2) mega(Args args) {
  extern __shared__ __attribute__((aligned(16))) unsigned char lds[];
  cg::grid_group grid = cg::this_grid();
  const int lo = args.ph_lo, hi = args.ph_hi;
  if (lo < 0) grid.sync();
  { volatile LAS unsigned* st0 = (volatile LAS unsigned*)((LAS unsigned char*)lds + XB_LDS_OFF); if (threadIdx.x < 4) st0[threadIdx.x] = 0u; }
  __syncthreads();
  XcdBarrier xbar = xcd_barrier_post((unsigned*)(args.ws + WS_CTL), (volatile LAS unsigned*)((LAS unsigned char*)lds + XB_LDS_OFF));
#define IN(k) (lo <= (k) && (k) < hi)
#define SEAM(k) do { if ((k) + 1 < hi) { xcd_barrier(xbar); } } while (0)
#define FRAME const int tid = threadIdx.x, lane = tid & 63, wave = __builtin_amdgcn_readfirstlane(tid >> 6); const int G = gridDim.x, bx = blockIdx.x; \
    const int vcu = (G % 8 == 0) ? (bx % 8) * (G / 8) + bx / 8 : bx; const int gw = vcu * 8 + wave, ngw = G * 8; unsigned char* ws = args.ws; float* part = (float*)(ws + WS_PART); (void)lane; (void)gw; (void)ngw; (void)part; (void)ws;
#define ROWOP(k) if (IN(k)) { FRAME do_row(args, (k), gw, ngw, lane); SEAM(k); }
  if (IN(0)) { FRAME do_p0(args, gw, ngw, lane, wave, lds);
#ifdef DBL_P0
    __syncthreads(); do_p0(args, gw, ngw, lane, wave, lds);
#endif
    SEAM(0); }
  if (IN(1)) { FRAME gemm_t<NT_, 5120, 1024, 0>(WSB(WS_A), WSB(W_HGIN), WSB(WS_BIG0), nullptr, part, lds); SEAM(1); }
  if (IN(2)) { FRAME for (int rep = 0; rep < SCAN_REPS; ++rep) for (int c = vcu; c < 256; c += G) gla::scan_chain(WSB(WS_BIG0), (const float*)(ws + WS_LB), WSB(WS_A), WSB(WS_B), c, (char*)lds); SEAM(2); }
  if (IN(3)) { FRAME comb_phase(WSB(WS_A), WSB(WS_B), WSB(WS_BIG0), args.in[14], gw, ngw, lane); SEAM(3); }
  if (IN(4)) { FRAME gemm_t<NT_, 1024, 1024, 2>(WSB(WS_A), WSB(W_HGOUT), WSB(WS_B), nullptr, part, lds); SEAM(4); }
  if (IN(5)) { FRAME do_row(args, 5, gw, ngw, lane);
#ifdef DBL_ROW5
    do_row(args, 5, gw, ngw, lane);
#endif
    SEAM(5); }
  if (IN(6)) { FRAME gemm_t<NT_, 4096, 1024, 6>((const bf16_t*)args.out, WSB(W_UP), WSB(WS_HID), nullptr, (float*)(ws + WS_RS), lds); SEAM(6); }
  if (IN(7)) { FRAME gemm_t<NT_, 1024, 4096, 2>(WSB(WS_HID), WSB(W_DN), WSB(WS_B), nullptr, part, lds); }
  if (IN(8)) { FRAME gemm_t<NT_, 1024, 256, 0>(WSB(WS_P16), WSB(W_PP), WSB(WS_BIG0), nullptr, part, lds); SEAM(8); }
  ROWOP(9)
  if (IN(10)) { FRAME gemm_t<NT_, 1024, 1024, 3>((const bf16_t*)args.out, WSB(W_PG), WSB(WS_B), WSB(WS_BIG0), part, lds); SEAM(10); }
  ROWOP(11)
  if (IN(12)) { FRAME gemm_t<NT_, 768, 1024, 7>((const bf16_t*)args.out, WSB(W_MLAIN), WSB(WS_B), nullptr, (float*)(ws + WS_RS), lds); SEAM(12); }
  if (IN(13)) { FRAME rn_phase(WSB(WS_B), args.in[17], args.in[19], (const float2*)(ws + WS_CS), WSB(WS_CQ), WSB(WS_CKV), WSB(WS_KR), gw, ngw, lane); SEAM(13); }
  if (IN(14)) { FRAME gemm_t<32768, 3072, 384, 0>(WSB(WS_CQ), WSB(W_UQ), WSB(WS_QH), nullptr, part, lds); }
  if (IN(15)) { FRAME gemm_t<32768, 4096, 256, 0>(WSB(WS_CKV), WSB(W_UKV), WSB(WS_KVH), nullptr, part, lds); SEAM(15); }
  if (IN(16)) { FRAME do_att(args, 0, vcu, lds);
#ifdef DBL_ATT
    do_att(args, 0, vcu, lds);
#endif
    SEAM(16); }
  if (IN(17)) { FRAME gemm_t<32768, 3072, 384, 0>(WSB(WS_CQ) + (size_t)32768 * 384, WSB(W_UQ), WSB(WS_QH), nullptr, part, lds); }
  if (IN(18)) { FRAME gemm_t<32768, 4096, 256, 0>(WSB(WS_CKV) + (size_t)32768 * 256, WSB(W_UKV), WSB(WS_KVH), nullptr, part, lds); SEAM(18); }
  if (IN(19)) { FRAME do_att(args, 1, vcu, lds);
#ifdef DBL_ATT
    do_att(args, 1, vcu, lds);
#endif
    SEAM(19); }
  if (IN(20)) { FRAME gemm_t<NT_, 1024, 2048, 2>(WSB(WS_A), WSB(W_O), WSB(WS_M3), nullptr, part, lds); SEAM(20); }
  ROWOP(21)
  if (IN(22)) { FRAME gemm_t<NT_, 4096, 1024, 6>((const bf16_t*)args.out, WSB(W_UP + 8 * MiB), WSB(WS_HID), nullptr, (float*)(ws + WS_RS), lds); SEAM(22); }
  if (IN(23)) { FRAME gemm_t<NT_, 1024, 4096, 2>(WSB(WS_HID), WSB(W_DN + 8 * MiB), WSB(WS_B), nullptr, part, lds); }
  if (IN(24)) { FRAME gemm_t<NT_, 1024, 256, 0>(WSB(WS_P16), WSB(W_PP + 512 * 1024), WSB(WS_A), nullptr, part, lds); SEAM(24); }
  ROWOP(25)
  if (IN(26)) { FRAME gemm_t<NT_, 1024, 1024, 3>(WSB(WS_BIG0), WSB(W_PG + 2 * MiB), WSB(WS_B), WSB(WS_A), part, lds); SEAM(26); }
  ROWOP(27)
#ifdef DUMP_MODE
  { FRAME asm volatile("s_waitcnt vmcnt(0) lgkmcnt(0)" ::: "memory"); __builtin_amdgcn_fence(__ATOMIC_RELEASE, "agent"); grid.sync(); __builtin_amdgcn_fence(__ATOMIC_ACQUIRE, "agent");
    for (size_t i = (size_t)bx * 512 + tid; i < (size_t)NT_ * DM; i += (size_t)G * 512) { const size_t row = i >> 10, c = i & 1023; float v = 0.f;
      if (DUMP_MODE == 1) v = bf_lo(WSB(WS_A)[i]);
      else if (DUMP_MODE == 2) { for (int j = 0; j < 5; ++j) v += bf_lo(WSB(WS_BIG0)[row * 5120 + c + 1024 * j]); }
      else if (DUMP_MODE == 3) v = bf_lo(WSB(WS_A)[i]) + bf_lo(WSB(WS_B)[i]);
      else if (DUMP_MODE == 4) v = bf_lo(WSB(WS_B)[i]);
      if (!(fabsf(v) < 1e30f)) v = 12345.f;
      args.out[i] = v; } }
#endif
#undef IN
#undef SEAM
#undef FRAME
#undef ROWOP
}
#undef WSB

#ifndef N_LAUNCH_MODE
#define N_LAUNCH_MODE 0
#endif
extern "C" void kernel_launch(void* const* d_in, const int* in_sizes, int n_in, void* d_out, int out_size, void* d_ws, size_t ws_size, hipStream_t stream) {
  static int grid = 0;
  if (grid == 0) {
    if (n_in != 22 || out_size != NT_ * DM || ws_size < WS_NEED) { fprintf(stderr, "kernel_launch: unexpected shapes n_in %d out %d ws %zu\n", n_in, out_size, ws_size); grid = -1; return; }
    int dev = 0, cus = 0, per_cu = 0;
    hipGetDevice(&dev); hipDeviceGetAttribute(&cus, hipDeviceAttributeMultiprocessorCount, dev);
    if (hipFuncSetAttribute((const void*)mega, hipFuncAttributeMaxDynamicSharedMemorySize, LDS_BYTES) != hipSuccess) { fprintf(stderr, "kernel_launch: hipFuncSetAttribute failed\n"); grid = -1; return; }
    if (hipOccupancyMaxActiveBlocksPerMultiprocessor(&per_cu, (const void*)mega, 512, LDS_BYTES) != hipSuccess || per_cu < 1) { fprintf(stderr, "kernel_launch: occupancy query gives %d\n", per_cu); per_cu = 1; }
    (void)hipGetLastError();
    grid = cus * 1;
  }
  if (grid < 0) return;
  Args a{};
  for (int i = 0; i < 22; ++i) a.in[i] = (const float*)d_in[i];
  a.out = (float*)d_out; a.ws = (unsigned char*)d_ws;
  if (hipMemsetAsync((char*)d_ws + WS_CTL, 0, CTL_BYTES, stream) != hipSuccess) { fprintf(stderr, "kernel_launch: memset failed\n"); return; }
#if N_LAUNCH_MODE == 0
#ifndef STOP_AT
#define STOP_AT N_OPS
#endif
  a.ph_lo = 0; a.ph_hi = STOP_AT;
  void* kargs[] = {&a};
  hipError_t e = hipLaunchCooperativeKernel((const void*)mega, dim3(grid), dim3(512), kargs, LDS_BYTES, stream);
  if (e != hipSuccess) fprintf(stderr, "cooperative launch failed: %s (grid %d)\n", hipGetErrorString(e), grid);
#else
  const int cuts[] = {0, 1, 2, 3, 4, 5, 6, 7, 9, 10, 11, 12, 13, 14, 16, 17, 19, 20, 21, 22, 23, 25, 26, 27, 28};
  for (unsigned i = 0; i + 1 < sizeof(cuts) / sizeof(int); ++i) { a.ph_lo = cuts[i]; a.ph_hi = cuts[i + 1]; hipLaunchKernelGGL(mega, dim3(grid), dim3(512), LDS_BYTES, stream, a); }
#endif
}
```

```cpp
#include <hip/hip_runtime.h>
#include <hip/hip_cooperative_groups.h>
#include <cstdio>
#include <cstdint>
namespace cg = cooperative_groups;
namespace pg8 {
#define PG8_LAS __attribute__((address_space(3)))
typedef unsigned short bf16_t;
typedef short bf16x8 __attribute__((ext_vector_type(8)));
typedef float f32x4 __attribute__((ext_vector_type(4)));
typedef unsigned u32x4 __attribute__((ext_vector_type(4)));
constexpr int BM = 256, BK = 64, HALF = 128, HTB = HALF * BK * 2  , STAGE_BYTES = 8 * HTB, NXCD = 8, WGM = 4;

__host__ __device__ __forceinline__ int lds_byte(int r, int c) { const int st = (r >> 4) * 2 + (c >> 5), rr = r & 15, cc = c & 31, ob = rr * 64 + cc * 2; return st * 1024 + (ob ^ (((ob >> 9) & 1) << 5)); }
__host__ __device__ __forceinline__ void stage_rc(int b, int& R, int& C) { const int st = b / 1024, sb = b % 1024, swz = sb ^ (((sb >> 9) & 1) << 5); R = (st >> 1) * 16 + swz / 64; C = (st & 1) * 32 + (swz % 64) / 2; }
__host__ __device__ __forceinline__ int perm32(int rho) { const int n = rho >> 4, i = rho & 15; return 8 * (i >> 2) + 4 * n + (i & 3); }

struct Unit { int pm, pn; };
struct Gemm { const bf16_t* A; const bf16_t* Bt; int M, N, K; };

struct StaticOrder {
    int nM, nN, nwg, G, c;
    __host__ __device__ void init(int M, int N, int G_, int c_) { nM = M / BM; nN = N / BM; nwg = nM * nN; G = G_; c = c_; }
    __host__ __device__ bool next(int i, Unit& u) const {
        const long L = (long)i * G + c; if (L >= nwg) return false;
        int wgid = (int)L; { const int q = nwg / NXCD, r = nwg % NXCD, xcd = wgid % NXCD, off = wgid / NXCD; wgid = (xcd < r ? xcd * (q + 1) : r * (q + 1) + (xcd - r) * q) + off; }
        const int nig = WGM * nN, gid = wgid / nig, fm = gid * WGM, gsz = (nM - fm) < WGM ? (nM - fm) : WGM;
        u.pm = fm + ((wgid % nig) % gsz); u.pn = (wgid % nig) / gsz; return true;
    }
    __device__ __forceinline__ void a_ready(const Unit&) const {}
    __device__ __forceinline__ void done(const Unit&) const {}
};

__device__ __forceinline__ unsigned cvt_pk_bf16(float lo, float hi) { unsigned r; asm volatile("v_cvt_pk_bf16_f32 %0, %1, %2" : "=v"(r) : "v"(lo), "v"(hi)); return r; }
typedef float f32x2_t __attribute__((ext_vector_type(2))); typedef __bf16 bf16x2_t __attribute__((ext_vector_type(2)));
__device__ __forceinline__ unsigned cvt_pk_safe(float lo, float hi) { f32x2_t v = {lo, hi}; bf16x2_t b = __builtin_convertvector(v, bf16x2_t); return __builtin_bit_cast(unsigned, b); }
template <int mode> struct EpiGen {
    static constexpr bool PERM = true, AFTER_DRAIN = false;
    bf16_t* O; int ldc; float* part; const bf16_t* E;
    __device__ __forceinline__ void operator()(const f32x4 (&acc)[2][2][4][2], const Unit& u, int wr, int wc, int fr, int fq) const {
        const int row0 = u.pm * BM + wr * 64 + fr, col0 = u.pn * BM + wc * 32 + 8 * fq;
#pragma unroll
        for (int ai = 0; ai < 2; ++ai)
#pragma unroll
            for (int m = 0; m < 4; ++m) {
                const int row = row0 + ai * HALF + m * 16;
                bf16_t* rowp = O + (size_t)row * ldc + col0;
                float ss = 0.f;
                const float rsc = (mode >= 6) ? part[row] : 1.f;
#pragma unroll
                for (int bj = 0; bj < 2; ++bj) {
                    f32x4 v0 = acc[ai][bj][m][0], v1 = acc[ai][bj][m][1];
                    if (mode >= 6) { v0 = v0 * rsc; v1 = v1 * rsc; }
                    if (mode == 1 || mode == 6) {
#pragma unroll
                        for (int i = 0; i < 4; ++i) { float a = fmaxf(v0[i], 0.f), b = fmaxf(v1[i], 0.f); v0[i] = a * a; v1[i] = b * b; }
                    } else if (mode == 3) {
                        const u32x4 e = *(const u32x4*)(E + (size_t)row * ldc + col0 + bj * HALF);
                        float ef[8];
#pragma unroll
                        for (int i = 0; i < 4; ++i) { ef[2 * i] = __uint_as_float(e[i] << 16); ef[2 * i + 1] = __uint_as_float(e[i] & 0xffff0000u); }
#pragma unroll
                        for (int i = 0; i < 4; ++i) { v0[i] = ef[i] / (1.f + __expf(-v0[i])); v1[i] = ef[4 + i] / (1.f + __expf(-v1[i])); }
                    }
                    if (mode == 2 || mode == 3) ss += (v0[0] * v0[0] + v0[1] * v0[1]) + (v0[2] * v0[2] + v0[3] * v0[3]) + (v1[0] * v1[0] + v1[1] * v1[1]) + (v1[2] * v1[2] + v1[3] * v1[3]);
                    u32x4 w; w.x = cvt_pk_safe(v0[0], v0[1]); w.y = cvt_pk_safe(v0[2], v0[3]); w.z = cvt_pk_safe(v1[0], v1[1]); w.w = cvt_pk_safe(v1[2], v1[3]);
                    *(u32x4*)(rowp + bj * HALF) = w;
                }
                if (mode == 2 || mode == 3) { ss += __shfl_xor(ss, 16); ss += __shfl_xor(ss, 32); if (fq == 0) part[(size_t)row * 16 + u.pn * 4 + wc] = ss; }
            }
    }
};
template <class Epi, class Sched, bool ALIGN_EPI = false, bool SP2 = false>
__device__ __forceinline__ void gemm_phase(PG8_LAS unsigned char* lds, const Gemm g, const Sched& S, const Epi& E) {
    const int tid = threadIdx.x, wid = __builtin_amdgcn_readfirstlane(tid >> 6), lane = tid & 63, wr = wid >> 2, wc = wid & 3, fr = lane & 15, fq = lane >> 4;
    const int K = g.K, nt = K / BK;
    unsigned voffA[2], voffB[2];
#pragma unroll
    for (int i = 0; i < 2; ++i) { int R, C; stage_rc(tid * 16 + i * 8192, R, C); const int Rb = Epi::PERM ? ((R & ~31) + perm32(R & 31)) : R;
        voffA[i] = (unsigned)(R * K + C) * 2u; voffB[i] = (unsigned)(Rb * K + C) * 2u; }
    const size_t kstep = (size_t)(BK * 2);
    const size_t hstep = (size_t)HALF * K * 2;
    const size_t tstep = 2 * hstep;
    const unsigned ldsw = (unsigned)wid * 1024u;
    const int aoff = lds_byte(wr * 64 + fr, fq * 8), boff = lds_byte(wc * 32 + fr, fq * 8);
#define PG8_SA(b, h) (((b) * 2 + (h)) * HTB)
#define PG8_SB(b, h) ((4 + (b) * 2 + (h)) * HTB)
#define PG8_STAGE(bufoff, gbase, voff) do { _Pragma("unroll") for (int _i = 0; _i < 2; ++_i) \
        __builtin_amdgcn_global_load_lds((const unsigned*)((const char*)(gbase) + (voff)[_i]), (PG8_LAS unsigned*)(lds + (bufoff) + ldsw + _i * 8192), 16, 0, 0); } while (0)
#define PG8_LDA(dst, b, h) do { _Pragma("unroll") for (int m = 0; m < 4; ++m) _Pragma("unroll") for (int k = 0; k < 2; ++k) dst[m][k] = *(const PG8_LAS bf16x8*)(lds + PG8_SA(b, h) + aoff + m * 2048 + k * 1024); } while (0)
#define PG8_LDB(dst, b, h) do { _Pragma("unroll") for (int n = 0; n < 2; ++n) _Pragma("unroll") for (int k = 0; k < 2; ++k) dst[n][k] = *(const PG8_LAS bf16x8*)(lds + PG8_SB(b, h) + boff + n * 2048 + k * 1024); } while (0)
#define PG8_MMA(ai, bj, At, Bt) do { __builtin_amdgcn_s_setprio(1); _Pragma("unroll") for (int m = 0; m < 4; ++m) _Pragma("unroll") for (int n = 0; n < 2; ++n) _Pragma("unroll") for (int k = 0; k < 2; ++k) \
        acc[ai][bj][m][n] = __builtin_amdgcn_mfma_f32_16x16x32_bf16(Bt[n][k], At[m][k], acc[ai][bj][m][n], 0, 0, 0); __builtin_amdgcn_s_setprio(0); } while (0)
#define PG8_WAIT_V(n) asm volatile("s_waitcnt vmcnt(" #n ")" ::: "memory")
#define PG8_WAIT_L(n) asm volatile("s_waitcnt lgkmcnt(" #n ")" ::: "memory")
#define PG8_BAR __builtin_amdgcn_s_barrier()
#define PG8_SCHED __builtin_amdgcn_sched_barrier(0)
    Unit cur, nxt; int ui = 0;
    if (!S.next(0, cur)) return;
    f32x4 acc[2][2][4][2];
#pragma unroll
    for (int a = 0; a < 2; ++a)
#pragma unroll
        for (int b = 0; b < 2; ++b)
#pragma unroll
            for (int m = 0; m < 4; ++m)
#pragma unroll
                for (int n = 0; n < 2; ++n) acc[a][b][m][n] = (f32x4){0.f, 0.f, 0.f, 0.f};
    bf16x8 At[4][2], B0[2][2], B1[2][2];
    const char* cA = (const char*)g.A + (size_t)cur.pm * tstep; const char* cB = (const char*)g.Bt + (size_t)cur.pn * tstep;
    S.a_ready(cur);
    if constexpr (SP2) {
        PG8_STAGE(PG8_SB(0, 0), cB, voffB); PG8_STAGE(PG8_SB(0, 1), cB + hstep, voffB); PG8_STAGE(PG8_SA(0, 0), cA, voffA); PG8_STAGE(PG8_SA(0, 1), cA + hstep, voffA);
        if (wr == 1) PG8_BAR;
        PG8_WAIT_V(2); PG8_BAR;
        PG8_STAGE(PG8_SB(1, 0), cB + kstep, voffB); PG8_STAGE(PG8_SA(1, 0), cA + kstep, voffA); PG8_STAGE(PG8_SB(1, 1), cB + hstep + kstep, voffB);
        PG8_WAIT_V(6); PG8_BAR;
    } else {
        PG8_STAGE(PG8_SB(0, 0), cB, voffB); PG8_STAGE(PG8_SA(0, 0), cA, voffA); PG8_STAGE(PG8_SB(0, 1), cB + hstep, voffB); PG8_STAGE(PG8_SA(0, 1), cA + hstep, voffA);
        if (wr == 1) PG8_BAR;
        PG8_WAIT_V(4); PG8_BAR;
        PG8_STAGE(PG8_SB(1, 0), cB + kstep, voffB); PG8_STAGE(PG8_SA(1, 0), cA + kstep, voffA); PG8_STAGE(PG8_SB(1, 1), cB + hstep + kstep, voffB);
        PG8_WAIT_V(6); PG8_BAR;
    }
    for (;;) {
        const bool has_next = S.next(ui + 1, nxt);
        const char* nA = has_next ? (const char*)g.A + (size_t)nxt.pm * tstep : cA; const char* nB = has_next ? (const char*)g.Bt + (size_t)nxt.pn * tstep : cB;
        for (int t = 0; t < nt; t += 2) {
            const bool last = (t == nt - 2);
            const char* a1 = cA + (size_t)(t + 1) * kstep;
            const char* a2 = last ? nA : cA + (size_t)(t + 2) * kstep; const char* b2 = last ? nB : cB + (size_t)(t + 2) * kstep;
            const char* a3 = a2 + kstep; const char* b3 = b2 + kstep;
            if (last && has_next) S.a_ready(nxt);
            if constexpr (SP2) {
            PG8_LDB(B0, 0, 0); PG8_LDB(B1, 0, 1); PG8_SCHED; PG8_LDA(At, 0, 0); PG8_STAGE(PG8_SA(1, 1), a1 + hstep, voffA);
            PG8_WAIT_V(8); PG8_WAIT_L(0); PG8_BAR; PG8_MMA(0, 0, At, B0); PG8_MMA(0, 1, At, B1); PG8_BAR; PG8_SCHED;
            PG8_LDA(At, 0, 1); PG8_STAGE(PG8_SB(0, 0), b2, voffB); PG8_STAGE(PG8_SB(0, 1), b2 + hstep, voffB); PG8_STAGE(PG8_SA(0, 0), a2, voffA);
            PG8_WAIT_V(8); PG8_WAIT_L(0); PG8_BAR; PG8_MMA(1, 0, At, B0); PG8_MMA(1, 1, At, B1); PG8_BAR; PG8_SCHED;
            PG8_LDB(B0, 1, 0); PG8_LDB(B1, 1, 1); PG8_SCHED; PG8_LDA(At, 1, 0); PG8_STAGE(PG8_SA(0, 1), a2 + hstep, voffA);
            PG8_WAIT_V(8); PG8_WAIT_L(0); PG8_BAR; PG8_MMA(0, 0, At, B0); PG8_MMA(0, 1, At, B1); PG8_BAR; PG8_SCHED;
            PG8_LDA(At, 1, 1); PG8_STAGE(PG8_SB(1, 0), b3, voffB); PG8_STAGE(PG8_SB(1, 1), b3 + hstep, voffB); PG8_STAGE(PG8_SA(1, 0), a3, voffA);
            PG8_WAIT_V(8); PG8_WAIT_L(0); PG8_BAR; PG8_MMA(1, 0, At, B0); PG8_MMA(1, 1, At, B1); PG8_BAR; PG8_SCHED;
            } else {
            PG8_LDB(B0, 0, 0); PG8_SCHED; PG8_LDA(At, 0, 0); PG8_STAGE(PG8_SA(1, 1), a1 + hstep, voffA);
            PG8_WAIT_L(8); PG8_BAR; PG8_WAIT_L(0); PG8_MMA(0, 0, At, B0); PG8_BAR; PG8_SCHED;
            PG8_LDB(B1, 0, 1); PG8_STAGE(PG8_SB(0, 0), b2, voffB);
            PG8_BAR; PG8_WAIT_L(0); PG8_MMA(0, 1, At, B1); PG8_BAR;
            PG8_LDA(At, 0, 1); PG8_STAGE(PG8_SA(0, 0), a2, voffA);
            PG8_BAR; PG8_WAIT_L(0); PG8_MMA(1, 0, At, B0); PG8_BAR; PG8_SCHED;
            PG8_STAGE(PG8_SB(0, 1), b2 + hstep, voffB);
            PG8_WAIT_V(6); PG8_BAR; PG8_MMA(1, 1, At, B1); PG8_BAR;
            PG8_LDB(B0, 1, 0); PG8_SCHED; PG8_LDA(At, 1, 0); PG8_STAGE(PG8_SA(0, 1), a2 + hstep, voffA);
            PG8_WAIT_L(8); PG8_BAR; PG8_WAIT_L(0); PG8_MMA(0, 0, At, B0); PG8_BAR; PG8_SCHED;
            PG8_LDB(B1, 1, 1); PG8_STAGE(PG8_SB(1, 0), b3, voffB);
            PG8_BAR; PG8_WAIT_L(0); PG8_MMA(0, 1, At, B1); PG8_BAR;
            PG8_LDA(At, 1, 1); PG8_STAGE(PG8_SA(1, 0), a3, voffA);
            PG8_BAR; PG8_WAIT_L(0); PG8_MMA(1, 0, At, B0); PG8_BAR; PG8_SCHED;
            PG8_STAGE(PG8_SB(1, 1), b3 + hstep, voffB);
            PG8_WAIT_V(6); PG8_BAR; PG8_MMA(1, 1, At, B1); PG8_BAR;
            }
        }
        if constexpr (ALIGN_EPI) { if (wr == 0) PG8_BAR; }
        if constexpr (!Epi::AFTER_DRAIN) { E(acc, cur, wr, wc, fr, fq); S.done(cur); }
        if (!has_next) break;
#pragma unroll
        for (int a = 0; a < 2; ++a)
#pragma unroll
            for (int b = 0; b < 2; ++b)
#pragma unroll
                for (int m = 0; m < 4; ++m)
#pragma unroll
                    for (int n = 0; n < 2; ++n) acc[a][b][m][n] = (f32x4){0.f, 0.f, 0.f, 0.f};
        cur = nxt; cA = nA; cB = nB; ++ui;
        if constexpr (ALIGN_EPI) { if (wr == 1) PG8_BAR; }
    }
    PG8_WAIT_V(0);
    if constexpr (!ALIGN_EPI) { if (wr == 0) PG8_BAR; }
    PG8_BAR;
    if constexpr (Epi::AFTER_DRAIN) { E.fused(acc, cur, wr, wc, fr, fq, lds, wid, lane); S.done(cur); }
#undef PG8_SA
#undef PG8_SB
#undef PG8_STAGE
#undef PG8_LDA
#undef PG8_LDB
#undef PG8_MMA
#undef PG8_WAIT_V
#undef PG8_WAIT_L
#undef PG8_BAR
#undef PG8_SCHED
}
}
namespace att {
typedef unsigned short bf16_t;
using bf16x8 = __attribute__((ext_vector_type(8))) short;
using s16x4  = __attribute__((ext_vector_type(4))) short;
using f32x16 = __attribute__((ext_vector_type(16))) float;
using u32x4  = __attribute__((ext_vector_type(4))) unsigned;
constexpr int NW = 8, QBLK = 32, KVBLK = 64;
constexpr float SCALE = 0.07216878364870323f;
constexpr float THR = 8.f;
#ifndef ATT_SDEPTH
#define ATT_SDEPTH 1
#endif
constexpr int SDEPTH = ATT_SDEPTH;
constexpr int LDQ = 3072, LDK = 4096, LDKR = 64, LDO = 2048;
constexpr int SHM_V = KVBLK * 128 * 2, SHM_K = KVBLK * 400, SHM_QR = 2 * SHM_V + 2 * SHM_K + NW * 64 * 4, SHM_ATTN = SHM_QR + NW * 4096;
#define KSWZ(row, colB) ((row) * 400 + (colB))
#define SBAR() __builtin_amdgcn_sched_barrier(0)
__device__ __forceinline__ int crow(int r, int hi) { return (r & 3) + 8 * (r >> 2) + 4 * hi; }
__device__ __forceinline__ unsigned cvtpk(float lo, float hi) { unsigned r; asm volatile("v_cvt_pk_bf16_f32 %0, %1, %2" : "=v"(r) : "v"(lo), "v"(hi)); return r; }
__device__ __forceinline__ bf16x8 ld8(const bf16_t* p) { return *reinterpret_cast<const bf16x8*>(p); }

__device__ __forceinline__ void partialSM(f32x16& p0, f32x16& p1, float& m_reg, float& mn, float& alpha) {
  constexpr float C = SCALE * 1.4426950408889634f;
  float pmax = p0[0];
#pragma unroll
  for (int r = 1; r < 16; ++r) pmax = fmaxf(pmax, p0[r]);
#pragma unroll
  for (int r = 0; r < 16; ++r) pmax = fmaxf(pmax, p1[r]);
  { auto rr = __builtin_amdgcn_permlane32_swap(__float_as_uint(pmax), __float_as_uint(pmax), false, false);
    pmax = fmaxf(__uint_as_float(rr[0]), __uint_as_float(rr[1])); }
  if (__builtin_expect(__all(pmax - m_reg <= THR / SCALE), 1)) { mn = m_reg; alpha = 1.f; }
  else { mn = fmaxf(m_reg, pmax); alpha = __builtin_amdgcn_exp2f((m_reg - mn) * C); m_reg = mn; }
  float mnC = -mn * C;
#pragma unroll
  for (int r = 0; r < 16; ++r) p0[r] = fmaf(p0[r], C, mnC);
#pragma unroll
  for (int r = 0; r < 16; ++r) p1[r] = fmaf(p1[r], C, mnC);
#pragma unroll
  for (int r = 0; r < 16; ++r) p0[r] = __builtin_amdgcn_exp2f(p0[r]);
}
__device__ __forceinline__ void finishSM(f32x16& p0, f32x16& p1, float alpha, float& l_reg, bf16x8& pa0, bf16x8& pa1, bf16x8& pa2, bf16x8& pa3) {
#pragma unroll
  for (int r = 0; r < 16; ++r) p1[r] = __builtin_amdgcn_exp2f(p1[r]);
  float ps = 0;
#pragma unroll
  for (int r = 0; r < 16; ++r) ps += p0[r];
#pragma unroll
  for (int r = 0; r < 16; ++r) ps += p1[r];
  { auto rr = __builtin_amdgcn_permlane32_swap(__float_as_uint(ps), __float_as_uint(ps), false, false);
    ps = __uint_as_float(rr[0]) + __uint_as_float(rr[1]); }
  l_reg = l_reg * alpha + ps;
#define PK4(P, BASE, OUT) do { unsigned a0 = cvtpk(P[BASE + 0], P[BASE + 1]), a1 = cvtpk(P[BASE + 2], P[BASE + 3]);   \
    unsigned b0 = cvtpk(P[BASE + 4], P[BASE + 5]), b1 = cvtpk(P[BASE + 6], P[BASE + 7]);                              \
    auto r0 = __builtin_amdgcn_permlane32_swap(a0, b0, false, false); auto r1 = __builtin_amdgcn_permlane32_swap(a1, b1, false, false); \
    u32x4 w = {r0[0], r1[0], r0[1], r1[1]}; OUT = *reinterpret_cast<bf16x8*>(&w); } while (0)
  PK4(p0, 0, pa0); PK4(p0, 8, pa1); PK4(p1, 0, pa2); PK4(p1, 8, pa3);
#undef PK4
}
__device__ __forceinline__ void qkt(f32x16& p0, f32x16& p1, const char* Ks, const bf16x8* qr, const char* qrl, int r32, int hi) {
  p0 = f32x16{}; p1 = f32x16{};
#pragma unroll
  for (int d0 = 0; d0 < 12; ++d0) { int cb = (d0 * 16 + hi * 8) * 2;
    bf16x8 b0 = *reinterpret_cast<const bf16x8*>(Ks + r32 * 400 + hi * 16 + d0 * 32);
    bf16x8 b1 = *reinterpret_cast<const bf16x8*>(Ks + r32 * 400 + hi * 16 + d0 * 32 + 32 * 400);
    const bf16x8 qf = (d0 < 8) ? qr[d0 < 8 ? d0 : 0] : *reinterpret_cast<const bf16x8*>(qrl + (d0 - 8) * 1024);
    p0 = __builtin_amdgcn_mfma_f32_32x32x16_bf16(b0, qf, p0, 0, 0, 0);
    p1 = __builtin_amdgcn_mfma_f32_32x32x16_bf16(b1, qf, p1, 0, 0, 0); }
}
__device__ __forceinline__ int v_st(int k, int c) { const int kk = (k & ~0xC) | ((k & 4) << 1) | ((k & 8) >> 1); return ((kk >> 3) * 4 + (c >> 5)) * 512 + ((kk & 7) * 32 + (c & 31)) * 2; }
__device__ __forceinline__ int v_rd_base(int lane) { return ((lane & 3) << 3) | (((lane >> 2) & 3) << 6) | (((lane >> 4) & 1) << 5) | (((lane >> 5) & 1) << 8); }
constexpr int v_rd_off(int d0, int ks, int half) { return d0 * 512 + ks * 4096 + half * 2048; }
template <int OFF> __device__ __forceinline__ s16x4 tr_read(int vb) {
  s16x4 r; asm volatile("ds_read_b64_tr_b16 %0, %1 offset:%2" : "=&v"(r) : "v"(vb), "i"(OFF) : "memory"); return r;
}
template <int D0> __device__ __forceinline__ void pv_one(f32x16& od, int vb, bf16x8 pa0, bf16x8 pa1, bf16x8 pa2, bf16x8 pa3) {
  const s16x4 l0 = tr_read<v_rd_off(D0, 0, 0)>(vb), h0 = tr_read<v_rd_off(D0, 0, 1)>(vb), l1 = tr_read<v_rd_off(D0, 1, 0)>(vb), h1 = tr_read<v_rd_off(D0, 1, 1)>(vb);
  const s16x4 l2 = tr_read<v_rd_off(D0, 2, 0)>(vb), h2 = tr_read<v_rd_off(D0, 2, 1)>(vb), l3 = tr_read<v_rd_off(D0, 3, 0)>(vb), h3 = tr_read<v_rd_off(D0, 3, 1)>(vb);
  asm volatile("s_waitcnt lgkmcnt(0)" ::: "memory"); SBAR();
#define PK(L, H) (bf16x8){L[0], L[1], L[2], L[3], H[0], H[1], H[2], H[3]}
  od = __builtin_amdgcn_mfma_f32_32x32x16_bf16(pa0, PK(l0, h0), od, 0, 0, 0);
  od = __builtin_amdgcn_mfma_f32_32x32x16_bf16(pa1, PK(l1, h1), od, 0, 0, 0);
  od = __builtin_amdgcn_mfma_f32_32x32x16_bf16(pa2, PK(l2, h2), od, 0, 0, 0);
  od = __builtin_amdgcn_mfma_f32_32x32x16_bf16(pa3, PK(l3, h3), od, 0, 0, 0);
#undef PK
}
__device__ __forceinline__ void pv_d0(f32x16* o, int vb, bf16x8 pa0, bf16x8 pa1, bf16x8 pa2, bf16x8 pa3) {
  pv_one<0>(o[0], vb, pa0, pa1, pa2, pa3); pv_one<1>(o[1], vb, pa0, pa1, pa2, pa3); pv_one<2>(o[2], vb, pa0, pa1, pa2, pa3); pv_one<3>(o[3], vb, pa0, pa1, pa2, pa3);
}
__device__ __forceinline__ float bf2f(short x) { return __uint_as_float(((unsigned)(unsigned short)x) << 16); }

__device__ __forceinline__ void attn_unit(const bf16_t* __restrict__ Qb, const bf16_t* __restrict__ Kh, const bf16_t* __restrict__ KRb, const float2* __restrict__ CSb,
                                          bf16_t* __restrict__ Ob, int seq, char* lds) {
  const int tid = threadIdx.x, wid = tid >> 6, lane = tid & 63, r32 = lane & 31, hi = lane >> 5;
  const bf16_t* Vh = Kh + 128;
  char* V_lds = lds; char* K_lds = lds + 2 * SHM_V;
  float* ws = (float*)(lds + 2 * SHM_V + 2 * SHM_K) + wid * 64; float* li_l = ws; float* al_l = ws + 32;
  float m_reg = -1e30f, l_reg = 0; f32x16 o[4] = {}; bf16x8 qr[8]; char* qrl = lds + SHM_QR + wid * 4096 + lane * 16;
  const bf16_t* Qw = Qb + (long)(wid * QBLK + r32) * LDQ + hi * 8;
#pragma unroll
  for (int d0 = 0; d0 < 8; ++d0) qr[d0] = ld8(Qw + d0 * 16);
  {
    const float2* cs = CSb + (long)(wid * QBLK + r32) * 32 + hi * 8;
#pragma unroll
    for (int dd = 0; dd < 2; ++dd) {
      const bf16x8 qa = ld8(Qw + (8 + dd) * 16), qb2 = ld8(Qw + (10 + dd) * 16);
      float o1[8], o2[8];
#pragma unroll
      for (int j = 0; j < 8; ++j) { const float2 c = cs[dd * 16 + j]; const float t1 = bf2f(qa[j]), t2 = bf2f(qb2[j]);
        o1[j] = t1 * c.x - t2 * c.y; o2[j] = t1 * c.y + t2 * c.x; }
      u32x4 w1 = {cvtpk(o1[0], o1[1]), cvtpk(o1[2], o1[3]), cvtpk(o1[4], o1[5]), cvtpk(o1[6], o1[7])};
      u32x4 w2 = {cvtpk(o2[0], o2[1]), cvtpk(o2[2], o2[3]), cvtpk(o2[4], o2[5]), cvtpk(o2[6], o2[7])};
      *reinterpret_cast<u32x4*>(qrl + dd * 1024) = w1; *reinterpret_cast<u32x4*>(qrl + (2 + dd) * 1024) = w2;
    }
  }
  const int sr = tid >> 4, sc = (tid & 15) * 8, vst0 = v_st(sr, sc);
  const int rr_ = tid >> 3, rc_ = (tid & 7) * 8;
  const int vb0 = (int)(uintptr_t)V_lds + v_rd_base(lane);
  struct { bf16x8 vs0, vs1, ks0, ks1, kr; } sr_[SDEPTH];
  const unsigned toff = (unsigned)(sr * LDK + sc), troff = (unsigned)(rr_ * LDKR + rc_);
#define SLOAD(i, k0) do { const bf16_t* kb_ = Kh + (size_t)(k0) * LDK; const bf16_t* rb_ = KRb + (size_t)(k0) * LDKR; \
    sr_[i].vs0 = ld8(kb_ + 128 + toff); sr_[i].vs1 = ld8(kb_ + 32 * LDK + 128 + toff); \
    sr_[i].ks0 = ld8(kb_ + toff); sr_[i].ks1 = ld8(kb_ + 32 * LDK + toff); \
    sr_[i].kr = ld8(rb_ + troff); } while (0)
  const int kst0 = KSWZ(sr, sc * 2), krst = KSWZ(rr_, 256 + rc_ * 2);
#define SWRITE(b, i) do { *(bf16x8*)(V_lds + (b) * SHM_V + vst0) = sr_[i].vs0;          \
    *(bf16x8*)(V_lds + (b) * SHM_V + 8192 + vst0) = sr_[i].vs1;               \
    *(bf16x8*)(K_lds + (b) * SHM_K + kst0) = sr_[i].ks0;                       \
    *(bf16x8*)(K_lds + (b) * SHM_K + 32 * 400 + kst0) = sr_[i].ks1;                  \
    *(bf16x8*)(K_lds + (b) * SHM_K + krst) = sr_[i].kr; } while (0)
#define SWAIT() do { if constexpr (SDEPTH == 2) asm volatile("s_waitcnt vmcnt(5)" ::: "memory"); else asm volatile("s_waitcnt vmcnt(0)" ::: "memory"); } while (0)
#define RESC(a) do { if (__any((a) < 1.f)) { if (hi == 0) al_l[r32] = (a); asm volatile("s_waitcnt lgkmcnt(0)" ::: "memory"); \
    _Pragma("unroll") for (int d = 0; d < 4; ++d) _Pragma("unroll") for (int r = 0; r < 16; ++r) o[d][r] *= al_l[crow(r, hi)]; } } while (0)
  f32x16 pA0, pA1, pB0, pB1; float mnA, mnB, alA, alB; bf16x8 pa0, pa1, pa2, pa3; const int NT = seq / KVBLK;
  constexpr int SE = 0, SO = SDEPTH - 1;
  SLOAD(SE, 0); asm volatile("s_waitcnt vmcnt(0)" ::: "memory"); SWRITE(0, SE); __syncthreads();
  qkt(pA0, pA1, K_lds, qr, qrl, r32, hi); partialSM(pA0, pA1, m_reg, mnA, alA);
  SLOAD(SO, KVBLK); if constexpr (SDEPTH == 2) { if (2 < NT) SLOAD(SE, 2 * KVBLK); }
  SWAIT(); SWRITE(1, SO); __syncthreads();
  for (int j = 1; j + 1 < NT; j += 2) {
    SBAR(); qkt(pB0, pB1, K_lds + SHM_K, qr, qrl, r32, hi);
    finishSM(pA0, pA1, alA, l_reg, pa0, pa1, pa2, pa3); SBAR();
    SLOAD(SO, (j + SDEPTH) * KVBLK); SBAR();
    pv_d0(o, vb0, pa0, pa1, pa2, pa3); partialSM(pB0, pB1, m_reg, mnB, alB);
    __syncthreads(); SWAIT(); SWRITE(0, SE);
    RESC(alB); __syncthreads();
    SBAR(); qkt(pA0, pA1, K_lds, qr, qrl, r32, hi);
    finishSM(pB0, pB1, alB, l_reg, pa0, pa1, pa2, pa3); SBAR();
    if (SDEPTH == 1 || j + 3 < NT) SLOAD(SE, (j + 1 + SDEPTH) * KVBLK); SBAR();
    pv_d0(o, vb0 + (int)SHM_V, pa0, pa1, pa2, pa3); partialSM(pA0, pA1, m_reg, mnA, alA);
    __syncthreads(); SWAIT(); SWRITE(1, SO);
    RESC(alA); __syncthreads();
  }
  SBAR(); qkt(pB0, pB1, K_lds + SHM_K, qr, qrl, r32, hi);
  finishSM(pA0, pA1, alA, l_reg, pa0, pa1, pa2, pa3); SBAR();
  pv_d0(o, vb0, pa0, pa1, pa2, pa3); partialSM(pB0, pB1, m_reg, mnB, alB);
  __syncthreads(); RESC(alB);
  finishSM(pB0, pB1, alB, l_reg, pa0, pa1, pa2, pa3); SBAR();
  pv_d0(o, vb0 + (int)SHM_V, pa0, pa1, pa2, pa3);
  if (hi == 0) li_l[r32] = l_reg; asm volatile("s_waitcnt lgkmcnt(0)" ::: "memory");
  float rli[16];
#pragma unroll
  for (int r = 0; r < 16; ++r) rli[r] = __builtin_amdgcn_rcpf(li_l[crow(r, hi)]);
  bf16_t* Ow = Ob + (long)(wid * QBLK) * LDO;
#pragma unroll
  for (int r = 0; r < 16; ++r) { int orow = crow(r, hi);
#pragma unroll
    for (int d0 = 0; d0 < 4; ++d0) { const unsigned w = cvtpk(o[d0][r] * rli[r], 0.f); Ow[(long)orow * LDO + d0 * 32 + r32] = (bf16_t)(w & 0xffffu); } }
  __syncthreads();
#undef SLOAD
#undef SWRITE
#undef SWAIT
#undef RESC
}
#undef KSWZ
#undef SBAR
}
namespace gla {
typedef unsigned short bf16_t;
typedef short bf16x8 __attribute__((ext_vector_type(8)));
typedef float f32x4 __attribute__((ext_vector_type(4)));
typedef unsigned u32x4 __attribute__((ext_vector_type(4)));
typedef unsigned u32x2 __attribute__((ext_vector_type(2)));
constexpr int PQ = 272, PT = 144;
constexpr int L_QD = 0, L_KI = L_QD + 64 * PQ, L_SB = L_KI + 64 * PQ, L_KET = L_SB + 128 * PQ, L_VT = L_KET + 128 * PT, L_AT = L_VT + 128 * PT, L_DEC = L_AT + 64 * PT, L_END = L_DEC + 512;
constexpr int PROJ_LD = 5120;
typedef float f32x2_t __attribute__((ext_vector_type(2))); typedef __bf16 bf16x2_t __attribute__((ext_vector_type(2)));
__device__ __forceinline__ unsigned cvtpk(float lo, float hi) { f32x2_t v = {lo, hi}; bf16x2_t b = __builtin_convertvector(v, bf16x2_t); return __builtin_bit_cast(unsigned, b); }
__device__ __forceinline__ float bflo(unsigned w) { return __uint_as_float(w << 16); }
__device__ __forceinline__ float bfhi(unsigned w) { return __uint_as_float(w & 0xffff0000u); }
template <int CTRL, int ROWM> __device__ __forceinline__ float dpp0(float v) { return __int_as_float(__builtin_amdgcn_update_dpp(0, __float_as_int(v), CTRL, ROWM, 0xf, false)); }
template <int CTRL, int ROWM> __device__ __forceinline__ float dpp1(float v) { return __int_as_float(__builtin_amdgcn_update_dpp(0x3f800000, __float_as_int(v), CTRL, ROWM, 0xf, false)); }
#define GBAR() asm volatile("s_waitcnt lgkmcnt(0)\n\ts_barrier" ::: "memory")
#define MFMA16(a, b, c) __builtin_amdgcn_mfma_f32_16x16x32_bf16((a), (b), (c), 0, 0, 0)
#define LDSV(off) (*(const bf16x8*)(lds + (off)))

struct ChunkRegs { u32x4 q[2], f[2], v[2]; };
__device__ __forceinline__ void load_chunk(ChunkRegs& c, const bf16_t* __restrict__ PROJ, int b, int cc, int tl, size_t colq, size_t colf, size_t colv) {
  const bf16_t* rp = PROJ + ((size_t)b * 4096 + cc * 64 + tl) * PROJ_LD;
  c.q[0] = *(const u32x4*)(rp + colq); c.q[1] = *(const u32x4*)(rp + colq + 8); c.f[0] = *(const u32x4*)(rp + colf); c.f[1] = *(const u32x4*)(rp + colf + 8);
  c.v[0] = *(const u32x4*)(rp + colv); c.v[1] = *(const u32x4*)(rp + colv + 8);
}
__device__ __forceinline__ void scan_step(const ChunkRegs& c, f32x4 (&sacc)[8], const float (&lbk)[16], bf16_t* __restrict__ Odir, char* lds,
                                          int b, int h, int dir, int cc, int wid, int lane, int fr, int fq, int kbase) {
    float P[16], k0[16];
#pragma unroll
    for (int kk = 0; kk < 16; ++kk) { const unsigned w = c.f[kk >> 3][(kk & 7) >> 1]; const float x = (kk & 1) ? bfhi(w) : bflo(w);
      const float e = __expf(-x), sg = __builtin_amdgcn_rcpf(1.f + e); const float oml = 1.f - lbk[kk];
      P[kk] = lbk[kk] + oml * sg; k0[kk] = oml * (e * sg); }
#pragma unroll
    for (int kk = 0; kk < 16; ++kk) { float v = P[kk];
      v *= dpp1<0x111, 0xf>(v); v *= dpp1<0x112, 0xf>(v); v *= dpp1<0x114, 0xf>(v); v *= dpp1<0x118, 0xf>(v);
      v *= dpp1<0x142, 0xa>(v); v *= dpp1<0x143, 0xc>(v);
      P[kk] = v; }
    float qd[16], ki[16];
#pragma unroll
    for (int kk = 0; kk < 16; ++kk) { const float Pl = __int_as_float(__builtin_amdgcn_readlane(__float_as_int(P[kk]), 63));
      const unsigned wq = c.q[kk >> 3][(kk & 7) >> 1]; const float q = (kk & 1) ? bfhi(wq) : bflo(wq);
      const unsigned wv = c.v[kk >> 3][(kk & 7) >> 1]; const float v = (kk & 1) ? bfhi(wv) : bflo(wv);
      qd[kk] = q * 0.08838834764831845f * P[kk]; ki[kk] = k0[kk] * __builtin_amdgcn_rcpf(P[kk]);
      const float ke = ki[kk] * Pl;
      *(bf16_t*)(lds + L_KET + (kbase + kk) * PT + lane * 2) = (bf16_t)(cvtpk(ke, 0.f) & 0xffffu);
      *(bf16_t*)(lds + L_VT + (kbase + kk) * PT + lane * 2) = (bf16_t)(cvtpk(v, 0.f) & 0xffffu); }
    if (lane == 63) {
#pragma unroll
      for (int g4 = 0; g4 < 4; ++g4) *(f32x4*)(lds + L_DEC + (kbase + 4 * g4) * 4) = (f32x4){P[4 * g4], P[4 * g4 + 1], P[4 * g4 + 2], P[4 * g4 + 3]}; }
#pragma unroll
    for (int g8 = 0; g8 < 2; ++g8) {
      u32x4 w; w.x = cvtpk(qd[8 * g8 + 0], qd[8 * g8 + 1]); w.y = cvtpk(qd[8 * g8 + 2], qd[8 * g8 + 3]); w.z = cvtpk(qd[8 * g8 + 4], qd[8 * g8 + 5]); w.w = cvtpk(qd[8 * g8 + 6], qd[8 * g8 + 7]);
      *(u32x4*)(lds + L_QD + lane * PQ + (kbase + 8 * g8) * 2) = w;
      u32x4 z; z.x = cvtpk(ki[8 * g8 + 0], ki[8 * g8 + 1]); z.y = cvtpk(ki[8 * g8 + 2], ki[8 * g8 + 3]); z.z = cvtpk(ki[8 * g8 + 4], ki[8 * g8 + 5]); z.w = cvtpk(ki[8 * g8 + 6], ki[8 * g8 + 7]);
      *(u32x4*)(lds + L_KI + lane * PQ + (kbase + 8 * g8) * 2) = z;
    }
    GBAR();
#pragma unroll
    for (int q2 = 0; q2 < 2; ++q2) { const int id = 2 * wid + q2, jt = id >> 2, it = id & 3;
      f32x4 cacc = (f32x4){0.f, 0.f, 0.f, 0.f};
      if (jt <= it) {
#pragma unroll
        for (int ks = 0; ks < 4; ++ks) { const bf16x8 a = LDSV(L_KI + (16 * jt + fr) * PQ + (32 * ks + 8 * fq) * 2); const bf16x8 bq = LDSV(L_QD + (16 * it + fr) * PQ + (32 * ks + 8 * fq) * 2); cacc = MFMA16(a, bq, cacc); }
      }
      const int i = 16 * it + fr, j0 = 16 * jt + 4 * fq;
      const float c0 = (j0 + 0 <= i) ? cacc[0] : 0.f, c1 = (j0 + 1 <= i) ? cacc[1] : 0.f, c2 = (j0 + 2 <= i) ? cacc[2] : 0.f, c3 = (j0 + 3 <= i) ? cacc[3] : 0.f;
      u32x2 w; w.x = cvtpk(c0, c1); w.y = cvtpk(c2, c3);
      *(u32x2*)(lds + L_AT + i * PT + j0 * 2) = w; }
    { const bf16x8 a0 = LDSV(L_KET + (kbase + fr) * PT + (8 * fq) * 2), a1 = LDSV(L_KET + (kbase + fr) * PT + (32 + 8 * fq) * 2);
      const f32x4 d4 = *(const f32x4*)(lds + L_DEC + (kbase + 4 * fq) * 4);
#pragma unroll
      for (int n = 0; n < 8; ++n) { const bf16x8 b0 = LDSV(L_VT + (16 * n + fr) * PT + (8 * fq) * 2), b1 = LDSV(L_VT + (16 * n + fr) * PT + (32 + 8 * fq) * 2);
        f32x4 t = sacc[n] * d4; t = MFMA16(a0, b0, t); sacc[n] = MFMA16(a1, b1, t); } }
    GBAR();
    { bf16x8 av[2], as[4];
#pragma unroll
      for (int ks = 0; ks < 2; ++ks) av[ks] = LDSV(L_VT + (kbase + fr) * PT + (32 * ks + 8 * fq) * 2);
#pragma unroll
      for (int ks = 0; ks < 4; ++ks) as[ks] = LDSV(L_SB + (kbase + fr) * PQ + (32 * ks + 8 * fq) * 2);
#pragma unroll
      for (int tt = 0; tt < 4; ++tt) { f32x4 cacc = (f32x4){0.f, 0.f, 0.f, 0.f};
#pragma unroll
        for (int ks = 0; ks < 2; ++ks) cacc = MFMA16(av[ks], LDSV(L_AT + (16 * tt + fr) * PT + (32 * ks + 8 * fq) * 2), cacc);
#pragma unroll
        for (int ks = 0; ks < 4; ++ks) cacc = MFMA16(as[ks], LDSV(L_QD + (16 * tt + fr) * PQ + (32 * ks + 8 * fq) * 2), cacc);
        const int t = 16 * tt + fr, tg = dir ? 63 - t : t;
        u32x2 w; w.x = cvtpk(cacc[0], cacc[1]); w.y = cvtpk(cacc[2], cacc[3]);
        *(u32x2*)(Odir + ((size_t)b * 4096 + cc * 64 + tg) * 1024 + h * 128 + kbase + 4 * fq) = w; } }
    GBAR();
#pragma unroll
    for (int n = 0; n < 8; ++n) { u32x2 w; w.x = cvtpk(sacc[n][0], sacc[n][1]); w.y = cvtpk(sacc[n][2], sacc[n][3]);
      *(u32x2*)(lds + L_SB + (16 * n + fr) * PQ + (kbase + 4 * fq) * 2) = w; }
}

__device__ __forceinline__ void scan_chain(const bf16_t* __restrict__ PROJ, const float* __restrict__ lbv, bf16_t* __restrict__ OF, bf16_t* __restrict__ OB, int chain, char* lds) {
  const int tid = threadIdx.x, wid = __builtin_amdgcn_readfirstlane(tid >> 6), lane = tid & 63, fr = lane & 15, fq = lane >> 4;
  const int dir = chain & 1, h = (chain >> 1) & 7, b = chain >> 4;
  bf16_t* Odir = dir ? OB : OF;
  const int kbase = 16 * wid;
  float lbk[16];
#pragma unroll
  for (int kk = 0; kk < 16; ++kk) lbk[kk] = lbv[h * 128 + kbase + kk];
  for (int i = tid; i < (128 * PQ) / 16; i += 512) *(u32x4*)(lds + L_SB + i * 16) = (u32x4){0u, 0u, 0u, 0u};
  f32x4 sacc[8];
#pragma unroll
  for (int n = 0; n < 8; ++n) sacc[n] = (f32x4){0.f, 0.f, 0.f, 0.f};
  const int tl = dir ? 63 - lane : lane;
  const size_t colq = (size_t)h * 128 + kbase, colf = 1024 + (size_t)dir * 1024 + colq, colv = 3072 + colq;
  ChunkRegs A, B;
  load_chunk(A, PROJ, b, dir ? 63 : 0, tl, colq, colf, colv);
  __syncthreads();
  for (int s = 0; s < 64; s += 2) {
    { const int cn = dir ? 62 - s : s + 1; load_chunk(B, PROJ, b, cn, tl, colq, colf, colv); }
    scan_step(A, sacc, lbk, Odir, lds, b, h, dir, dir ? 63 - s : s, wid, lane, fr, fq, kbase);
    if (s + 2 < 64) { const int cn = dir ? 61 - s : s + 2; load_chunk(A, PROJ, b, cn, tl, colq, colf, colv); }
    scan_step(B, sacc, lbk, Odir, lds, b, h, dir, dir ? 62 - s : s + 1, wid, lane, fr, fq, kbase);
  }
  __syncthreads();
}
#undef GBAR
#undef MFMA16
#undef LDSV
}
#define LAS __attribute__((address_space(3)))
#define XB_TMO      128
#define XB_XCNT(j)  (256  + 64 * (j))
#define XB_XSUB(j)  (1280 + 64 * (j))
#define XB_XGEN(j)  (2304 + 64 * (j))
#define XB_TOP      3328
#define XB_TOPGEN   3392
#define XCD_BAR_WORDS 3456
#define XB_SPIN_CAP (1u << 18)

__device__ __forceinline__ unsigned xb_ld(unsigned* p)              { return __hip_atomic_load(p, __ATOMIC_RELAXED, __HIP_MEMORY_SCOPE_AGENT); }
__device__ __forceinline__ unsigned xb_add(unsigned* p, unsigned v) { return __hip_atomic_fetch_add(p, v, __ATOMIC_RELAXED, __HIP_MEMORY_SCOPE_AGENT); }
__device__ __forceinline__ unsigned xb_xcc_id() { return (unsigned)__builtin_amdgcn_s_getreg((3 << 11) | 20) & 0xFu; }
#define XB_SPIN(cond, bar) do { unsigned _sp = 0; while (cond) { __builtin_amdgcn_s_sleep(1); \
    if ((++_sp & 255u) == 0u) { if (xb_ld(&(bar)[XB_TMO])) break; if (_sp > XB_SPIN_CAP) { atomicAdd(&(bar)[XB_TMO], 1u); break; } } } } while (0)

struct XcdBarrier {
    unsigned* bar; unsigned x;
    volatile LAS unsigned* st;
};

__device__ __forceinline__ XcdBarrier xcd_barrier_post(unsigned* bar, volatile LAS unsigned* st) {
    XcdBarrier b; b.bar = bar; b.x = xb_xcc_id(); b.st = st;
    if (threadIdx.x == 0) (void)xb_add(&bar[XB_XCNT(b.x)], 1u);
    return b;
}
__device__ __forceinline__ void xcd_barrier_complete(unsigned* bar, unsigned x, unsigned& nloc, unsigned& nx) {
    const unsigned G = gridDim.x * gridDim.y * gridDim.z;
    unsigned sum, cnt, mine, sp = 0u;
    for (;;) {
        sum = 0u; cnt = 0u; mine = 0u;
#pragma unroll
        for (unsigned j = 0; j < 16; ++j) { const unsigned c = xb_ld(&bar[XB_XCNT(j)]); sum += c; cnt += (c > 0u) ? 1u : 0u; mine = (j == x) ? c : mine; }
        if (sum == G) break;
        __builtin_amdgcn_s_sleep(1);
        if ((++sp & 255u) == 0u) { if (xb_ld(&bar[XB_TMO])) break; if (sp > XB_SPIN_CAP) { atomicAdd(&bar[XB_TMO], 1u); break; } }
    }
    nloc = mine > 0u ? mine : 1u; nx = cnt > 0u ? cnt : 1u;
}

__device__ __forceinline__ void xcd_barrier(const XcdBarrier& b) {
    asm volatile("s_waitcnt vmcnt(0)" ::: "memory");
    __syncthreads();
    if (threadIdx.x == 0) {
        unsigned* bar = b.bar;
        __builtin_amdgcn_s_waitcnt(0);
        unsigned nloc = b.st[0], nx = b.st[1];
        if (nloc == 0u) { xcd_barrier_complete(bar, b.x, nloc, nx); b.st[0] = nloc; b.st[1] = nx; }
        const unsigned old = xb_add(&bar[XB_XSUB(b.x)], 1u);
        const unsigned gen = old / nloc;
        if (old + 1u == (gen + 1u) * nloc) {
            __builtin_amdgcn_fence(__ATOMIC_RELEASE, "agent");
            asm volatile("s_waitcnt vmcnt(0)" ::: "memory");
            const unsigned og = xb_add(&bar[XB_TOP], 1u);
            const unsigned tg = og / nx;
            if (og + 1u == (tg + 1u) * nx) xb_add(&bar[XB_TOPGEN], 1u);
            else XB_SPIN(xb_ld(&bar[XB_TOPGEN]) == tg, bar);
            __builtin_amdgcn_fence(__ATOMIC_ACQUIRE, "agent");
            xb_add(&bar[XB_XGEN(b.x)], 1u);
            asm volatile("s_waitcnt vmcnt(0)" ::: "memory");
        } else {
            XB_SPIN(xb_ld(&bar[XB_XGEN(b.x)]) == gen, bar);
            __builtin_amdgcn_fence(__ATOMIC_ACQUIRE, "agent");
            asm volatile("s_waitcnt vmcnt(0)" ::: "memory");
        }
    }
    __syncthreads();
}
typedef unsigned short bf16_t;
typedef float f32x4 __attribute__((ext_vector_type(4)));
typedef unsigned u32x4 __attribute__((ext_vector_type(4)));
typedef unsigned u32x2 __attribute__((ext_vector_type(2)));
constexpr int NT_ = 65536, DM = 1024, SEQ = 4096, NB = 16, DFF = 4096;
constexpr float EPS = 1e-6f;
constexpr size_t MiB = 1u << 20;
constexpr size_t W_HGIN = 0, W_HGOUT = W_HGIN + 10 * MiB, W_UP = W_HGOUT + 2 * MiB  , W_DN = W_UP + 16 * MiB  , W_PP = W_DN + 16 * MiB  ,
                 W_PG = W_PP + 1 * MiB  , W_MLAIN = W_PG + 4 * MiB  , W_UQ = W_MLAIN + 1536 * 1024  , W_UKV = W_UQ + 2304 * 1024  , W_O = W_UKV + 2 * MiB  , W_END = W_O + 4 * MiB;
static_assert(W_END <= 59 * MiB, "weights");
constexpr size_t WS_PART = 59 * MiB, WS_LB = 63 * MiB, WS_P16 = 64 * MiB, WS_BIG0 = 96 * MiB, WS_HID = 224 * MiB, WS_A = 736 * MiB, WS_B = 864 * MiB, WS_CS = 992 * MiB;
constexpr size_t WS_CQ = 96 * MiB, WS_CKV = 144 * MiB, WS_KR = 176 * MiB, WS_QH = 192 * MiB, WS_KVH = 384 * MiB, WS_M3 = 384 * MiB;
constexpr size_t WS_NEED = 1008 * MiB;
constexpr size_t WS_RS = 63 * MiB + 64 * 1024;
constexpr int LDS_BYTES = 135168;
constexpr int XB_LDS_OFF = 131072 + 256;
constexpr size_t WS_CTL = 63 * MiB + 512 * 1024, CTL_BYTES = 16384;

typedef float f32x2_t __attribute__((ext_vector_type(2))); typedef __bf16 bf16x2_t __attribute__((ext_vector_type(2)));
__device__ __forceinline__ unsigned pk2(float lo, float hi) { f32x2_t v = {lo, hi}; bf16x2_t b = __builtin_convertvector(v, bf16x2_t); return __builtin_bit_cast(unsigned, b); }
__device__ __forceinline__ float wave_sum(float v) {
#pragma unroll
  for (int o = 1; o < 64; o <<= 1) v += __shfl_xor(v, o);
  return v;
}
__device__ __forceinline__ void transpose_item(const float* __restrict__ W, int K, int N, bf16_t* __restrict__ WT, float* scr, int item, int lane, const float* __restrict__ gk = nullptr) {
  const int nblk = N / 32, kb = item / nblk, nb = item % nblk, k0 = 64 * kb, n0 = 32 * nb;
  float wv[32];
#pragma unroll
  for (int i = 0; i < 32; ++i) { const int kk = 2 * i + (lane >> 5); wv[i] = W[(size_t)(k0 + kk) * N + n0 + (lane & 31)]; }
#pragma unroll
  for (int i = 0; i < 32; ++i) { const int kk = 2 * i + (lane >> 5); scr[kk * 33 + (lane & 31)] = gk ? wv[i] * gk[k0 + kk] : wv[i]; }
  asm volatile("s_waitcnt lgkmcnt(0)" ::: "memory");
  const int c = lane & 7;
#pragma unroll
  for (int j = 0; j < 4; ++j) { const int n = (lane >> 3) + 8 * j; const float* s = scr + (8 * c) * 33 + n;
    u32x4 o; o.x = pk2(s[0 * 33], s[1 * 33]); o.y = pk2(s[2 * 33], s[3 * 33]); o.z = pk2(s[4 * 33], s[5 * 33]); o.w = pk2(s[6 * 33], s[7 * 33]);
    *(u32x4*)(WT + (size_t)(n0 + n) * K + k0 + 8 * c) = o; }
  asm volatile("s_waitcnt lgkmcnt(0)" ::: "memory");
}

struct Args { const float* in[22]; float* out; unsigned char* ws; int ph_lo, ph_hi; };

struct RowOp { float* rsout; const bf16_t* hin16; bf16_t* hout16; const float* hin; const bf16_t* m; const float* part; const float* gpost; float* hout; bf16_t* aout; const float* gnext; const float* pin; bf16_t* p16; };
constexpr int RB = 4;
__device__ __forceinline__ void row_phase(const RowOp& r, int gw, int ngw, int lane) {
  for (int row0 = gw * RB; row0 < NT_; row0 += ngw * RB) {
    f32x4 v[RB][4]; u32x2 mm[RB][4]; float pp[RB];
    if (r.hin16) {
#pragma unroll
      for (int b = 0; b < RB; ++b) { const bf16_t* hr = r.hin16 + (size_t)(row0 + b) * DM + 4 * lane;
#pragma unroll
        for (int j = 0; j < 4; ++j) { const u32x2 hh = *(const u32x2*)(hr + 256 * j); v[b][j] = (f32x4){__uint_as_float(hh.x << 16), __uint_as_float(hh.x & 0xffff0000u), __uint_as_float(hh.y << 16), __uint_as_float(hh.y & 0xffff0000u)}; } }
    } else {
#pragma unroll
      for (int b = 0; b < RB; ++b) { const float* hr = r.hin + (size_t)(row0 + b) * DM + 4 * lane;
#pragma unroll
        for (int j = 0; j < 4; ++j) v[b][j] = *(const f32x4*)(hr + 256 * j); }
    }
    if (r.m) {
#pragma unroll
      for (int b = 0; b < RB; ++b) { pp[b] = r.part[(size_t)(row0 + b) * 16 + (lane & 15)]; const bf16_t* mr = r.m + (size_t)(row0 + b) * DM + 4 * lane;
#pragma unroll
        for (int j = 0; j < 4; ++j) mm[b][j] = *(const u32x2*)(mr + 256 * j); }
      f32x4 g[4];
#pragma unroll
      for (int j = 0; j < 4; ++j) g[j] = *(const f32x4*)(r.gpost + 4 * lane + 256 * j);
#pragma unroll
      for (int b = 0; b < RB; ++b) { float p_ = pp[b]; p_ += __shfl_xor(p_, 1); p_ += __shfl_xor(p_, 2); p_ += __shfl_xor(p_, 4); p_ += __shfl_xor(p_, 8);
        const float rs = rsqrtf(p_ * (1.f / DM) + EPS);
#pragma unroll
        for (int j = 0; j < 4; ++j) { const u32x2 m2 = mm[b][j];
          v[b][j][0] += __uint_as_float(m2.x << 16) * rs * g[j][0]; v[b][j][1] += __uint_as_float(m2.x & 0xffff0000u) * rs * g[j][1];
          v[b][j][2] += __uint_as_float(m2.y << 16) * rs * g[j][2]; v[b][j][3] += __uint_as_float(m2.y & 0xffff0000u) * rs * g[j][3]; } }
    }
    if (r.hout) {
#pragma unroll
      for (int b = 0; b < RB; ++b) { float* ho = r.hout + (size_t)(row0 + b) * DM + 4 * lane;
#pragma unroll
        for (int j = 0; j < 4; ++j) *(f32x4*)(ho + 256 * j) = v[b][j]; } }
    if (r.hout16) {
#pragma unroll
      for (int b = 0; b < RB; ++b) { bf16_t* ho = r.hout16 + (size_t)(row0 + b) * DM + 4 * lane;
#pragma unroll
        for (int j = 0; j < 4; ++j) { u32x2 w; w.x = pk2(v[b][j][0], v[b][j][1]); w.y = pk2(v[b][j][2], v[b][j][3]); *(u32x2*)(ho + 256 * j) = w; } } }
    if (r.rsout) {
      float ss[RB];
#pragma unroll
      for (int b = 0; b < RB; ++b) { ss[b] = 0.f;
#pragma unroll
        for (int j = 0; j < 4; ++j) ss[b] += (v[b][j][0] * v[b][j][0] + v[b][j][1] * v[b][j][1]) + (v[b][j][2] * v[b][j][2] + v[b][j][3] * v[b][j][3]); }
#pragma unroll
      for (int o = 1; o < 64; o <<= 1) {
#pragma unroll
        for (int b = 0; b < RB; ++b) ss[b] += __shfl_xor(ss[b], o); }
      if (lane < RB) { float sel = ss[0];
#pragma unroll
        for (int b = 1; b < RB; ++b) sel = (lane == b) ? ss[b] : sel;
        r.rsout[row0 + lane] = rsqrtf(sel * (1.f / DM) + EPS); }
    }
    if (r.aout) {
      if (r.gnext) {
        f32x4 g[4];
#pragma unroll
        for (int j = 0; j < 4; ++j) g[j] = *(const f32x4*)(r.gnext + 4 * lane + 256 * j);
        float ss[RB];
#pragma unroll
        for (int b = 0; b < RB; ++b) { ss[b] = 0.f;
#pragma unroll
          for (int j = 0; j < 4; ++j) ss[b] += (v[b][j][0] * v[b][j][0] + v[b][j][1] * v[b][j][1]) + (v[b][j][2] * v[b][j][2] + v[b][j][3] * v[b][j][3]); }
#pragma unroll
        for (int o = 1; o < 64; o <<= 1) {
#pragma unroll
          for (int b = 0; b < RB; ++b) ss[b] += __shfl_xor(ss[b], o); }
#pragma unroll
        for (int b = 0; b < RB; ++b) { const float rs2 = rsqrtf(ss[b] * (1.f / DM) + EPS); bf16_t* ao = r.aout + (size_t)(row0 + b) * DM + 4 * lane;
#pragma unroll
          for (int j = 0; j < 4; ++j) { u32x2 w; w.x = pk2(v[b][j][0] * rs2 * g[j][0], v[b][j][1] * rs2 * g[j][1]); w.y = pk2(v[b][j][2] * rs2 * g[j][2], v[b][j][3] * rs2 * g[j][3]); *(u32x2*)(ao + 256 * j) = w; } }
      } else {
#pragma unroll
        for (int b = 0; b < RB; ++b) { bf16_t* ao = r.aout + (size_t)(row0 + b) * DM + 4 * lane;
#pragma unroll
          for (int j = 0; j < 4; ++j) { u32x2 w; w.x = pk2(v[b][j][0], v[b][j][1]); w.y = pk2(v[b][j][2], v[b][j][3]); *(u32x2*)(ao + 256 * j) = w; } }
      }
    }
    if (r.pin) {
#pragma unroll
      for (int b = 0; b < RB; ++b) { const f32x4 pv = *(const f32x4*)(r.pin + (size_t)(row0 + b) * 256 + 4 * lane); u32x2 w; w.x = pk2(pv[0], pv[1]); w.y = pk2(pv[2], pv[3]); *(u32x2*)(r.p16 + (size_t)(row0 + b) * 256 + 4 * lane) = w; } }
  }
}

__device__ __forceinline__ float bf_lo(unsigned w) { return __uint_as_float(w << 16); }
__device__ __forceinline__ float bf_hi(unsigned w) { return __uint_as_float(w & 0xffff0000u); }

__device__ __forceinline__ void comb_phase(bf16_t* OF, const bf16_t* OB, const bf16_t* PROJ, const float* onorm, int gw, int ngw, int lane) {
  constexpr int CB = 2;
  float on[16];
#pragma unroll
  for (int i = 0; i < 16; ++i) on[i] = onorm[16 * lane + i];
  for (int row0 = gw * CB; row0 < NT_; row0 += ngw * CB) {
    u32x4 a[CB][2], bb[CB][2], gg[CB][2];
#pragma unroll
    for (int b = 0; b < CB; ++b) { const bf16_t* of = OF + (size_t)(row0 + b) * DM + 16 * lane; const bf16_t* ob = OB + (size_t)(row0 + b) * DM + 16 * lane; const bf16_t* gt = PROJ + (size_t)(row0 + b) * 5120 + 4096 + 16 * lane;
#pragma unroll
      for (int q = 0; q < 2; ++q) { a[b][q] = *(const u32x4*)(of + 8 * q); bb[b][q] = *(const u32x4*)(ob + 8 * q); gg[b][q] = *(const u32x4*)(gt + 8 * q); } }
#pragma unroll
    for (int b = 0; b < CB; ++b) {
      float s[16], g[16];
#pragma unroll
      for (int q = 0; q < 2; ++q)
#pragma unroll
        for (int i = 0; i < 4; ++i) { s[8 * q + 2 * i] = bf_lo(a[b][q][i]) + bf_lo(bb[b][q][i]); s[8 * q + 2 * i + 1] = bf_hi(a[b][q][i]) + bf_hi(bb[b][q][i]); g[8 * q + 2 * i] = bf_lo(gg[b][q][i]); g[8 * q + 2 * i + 1] = bf_hi(gg[b][q][i]); }
      float ss = 0.f;
#pragma unroll
      for (int i = 0; i < 16; ++i) ss += s[i] * s[i];
      ss += __shfl_xor(ss, 1); ss += __shfl_xor(ss, 2); ss += __shfl_xor(ss, 4);
      const float rs = rsqrtf(ss * (1.f / 128.f) + EPS);
      float o[16];
#pragma unroll
      for (int i = 0; i < 16; ++i) { const float gv = g[i]; o[i] = s[i] * rs * on[i] * (gv * __builtin_amdgcn_rcpf(1.f + __expf(-gv))); }
      bf16_t* of = OF + (size_t)(row0 + b) * DM + 16 * lane;
#pragma unroll
      for (int q = 0; q < 2; ++q) { u32x4 w; w.x = pk2(o[8 * q], o[8 * q + 1]); w.y = pk2(o[8 * q + 2], o[8 * q + 3]); w.z = pk2(o[8 * q + 4], o[8 * q + 5]); w.w = pk2(o[8 * q + 6], o[8 * q + 7]); *(u32x4*)(of + 8 * q) = w; }
    }
  }
}

__device__ __forceinline__ void rn_phase(const bf16_t* PRJ, const float* qn, const float* kvn, const float2* CS, bf16_t* CQ, bf16_t* CKV, bf16_t* KR, int gw, int ngw, int lane) {
  constexpr int NB = 4;
  float gq[6], gk[4];
#pragma unroll
  for (int j = 0; j < 3; ++j) { gq[2 * j] = qn[2 * lane + 128 * j]; gq[2 * j + 1] = qn[2 * lane + 128 * j + 1]; }
#pragma unroll
  for (int j = 0; j < 2; ++j) { gk[2 * j] = kvn[2 * lane + 128 * j]; gk[2 * j + 1] = kvn[2 * lane + 128 * j + 1]; }
  for (int row0 = gw * NB; row0 < NT_; row0 += ngw * NB) {
    unsigned wq[NB][3], wk[NB][2], wr[NB]; f32x4 cs[NB];
#pragma unroll
    for (int b = 0; b < NB; ++b) { const unsigned* pr = (const unsigned*)(PRJ + (size_t)(row0 + b) * 768);
#pragma unroll
      for (int j = 0; j < 3; ++j) wq[b][j] = pr[lane + 64 * j];
#pragma unroll
      for (int j = 0; j < 2; ++j) wk[b][j] = pr[192 + lane + 64 * j];
      wr[b] = pr[320 + (lane & 31)];
      cs[b] = *(const f32x4*)(CS + (size_t)(row0 + b) * 32 + 2 * (lane & 15)); }
#pragma unroll
    for (int b = 0; b < NB; ++b) {
      float q[6], c[4]; float sq = 0.f, sc = 0.f;
#pragma unroll
      for (int j = 0; j < 3; ++j) { q[2 * j] = bf_lo(wq[b][j]); q[2 * j + 1] = bf_hi(wq[b][j]); sq += q[2 * j] * q[2 * j] + q[2 * j + 1] * q[2 * j + 1]; }
#pragma unroll
      for (int j = 0; j < 2; ++j) { c[2 * j] = bf_lo(wk[b][j]); c[2 * j + 1] = bf_hi(wk[b][j]); sc += c[2 * j] * c[2 * j] + c[2 * j + 1] * c[2 * j + 1]; }
      const float rq = rsqrtf(wave_sum(sq) * (1.f / 384.f) + EPS), rc = rsqrtf(wave_sum(sc) * (1.f / 256.f) + EPS);
      unsigned* oq = (unsigned*)(CQ + (size_t)(row0 + b) * 384); unsigned* ok = (unsigned*)(CKV + (size_t)(row0 + b) * 256);
#pragma unroll
      for (int j = 0; j < 3; ++j) oq[lane + 64 * j] = pk2(q[2 * j] * rq * gq[2 * j], q[2 * j + 1] * rq * gq[2 * j + 1]);
#pragma unroll
      for (int j = 0; j < 2; ++j) ok[lane + 64 * j] = pk2(c[2 * j] * rc * gk[2 * j], c[2 * j + 1] * rc * gk[2 * j + 1]);
      const float k0 = bf_lo(wr[b]), k1 = bf_hi(wr[b]);
      const float p0 = __shfl_xor(k0, 16), p1 = __shfl_xor(k1, 16);
      const bool lo16 = (lane & 16) == 0;
      const float r0 = lo16 ? (k0 * cs[b][0] - p0 * cs[b][1]) : (p0 * cs[b][1] + k0 * cs[b][0]);
      const float r1 = lo16 ? (k1 * cs[b][2] - p1 * cs[b][3]) : (p1 * cs[b][3] + k1 * cs[b][2]);
      if (lane < 32) ((unsigned*)(KR + (size_t)(row0 + b) * 64))[lane] = pk2(r0, r1);
    }
  }
}

enum { OP_P0 = 0, OP_GEMM, OP_SCAN, OP_COMB, OP_ROW, OP_RN, OP_ATT };
constexpr int N_OPS = 28;
__device__ __forceinline__ int op_kind(int i) {
  switch (i) { case 0: return OP_P0; case 2: return OP_SCAN; case 3: return OP_COMB; case 13: return OP_RN; case 16: case 19: return OP_ATT;
    case 5: case 9: case 11: case 21: case 25: case 27: return OP_ROW; default: return OP_GEMM; }
}
__device__ __forceinline__ bool op_sync(int i) { return !(i == 7 || i == 14 || i == 17 || i == 23); }
#define WSB(off) ((bf16_t*)(ws + (off)))

#ifndef SCAN_REPS
#define SCAN_REPS 1
#endif
#ifndef GEMM_REPS
#define GEMM_REPS 1
#endif
template <int M, int N, int K, int MODE>
__device__ __forceinline__ void gemm_t(const bf16_t* A, const bf16_t* Bt, bf16_t* O, const bf16_t* E, float* part, unsigned char* lds) {
  pg8::Gemm g{A, Bt, M, N, K}; pg8::StaticOrder S; S.init(M, N, (int)gridDim.x, (int)blockIdx.x);
  pg8::EpiGen<MODE> Ep{O, N, part, E};
  pg8::gemm_phase<pg8::EpiGen<MODE>, pg8::StaticOrder, true, true>((PG8_LAS unsigned char*)lds, g, S, Ep);
  __syncthreads();
#if GEMM_REPS == 2
  pg8::gemm_phase<pg8::EpiGen<MODE>, pg8::StaticOrder, true, true>((PG8_LAS unsigned char*)lds, g, S, Ep);
  __syncthreads();
#endif
}
__device__ __forceinline__ void do_row(const Args& args, int opi, int gw, int ngw, int lane) {
  unsigned char* ws = args.ws; bf16_t* H16 = (bf16_t*)args.out;
  RowOp r; r.rsout = nullptr; r.hin16 = H16; r.hout16 = H16; r.hin = nullptr; r.m = WSB(WS_B); r.part = (const float*)(ws + WS_PART); r.gpost = nullptr; r.hout = nullptr; r.aout = nullptr; r.gnext = nullptr; r.pin = nullptr; r.p16 = WSB(WS_P16);
  switch (opi) {
    case 5: r.gpost = args.in[4];     r.rsout = (float*)(ws + WS_RS); r.pin = args.in[1]; break;
    case 9: r.gpost = args.in[6]; break;
    case 11: r.gpost = args.in[11]; r.rsout = (float*)(ws + WS_RS); break;
    case 21: r.m = WSB(WS_M3); r.gpost = args.in[4] + DM; r.rsout = (float*)(ws + WS_RS); r.pin = args.in[1] + (size_t)NT_ * 256; break;
    case 25: r.gpost = args.in[6] + DM; r.hout16 = WSB(WS_BIG0); break;
    default: r.hin16 = WSB(WS_BIG0); r.hout16 = nullptr; r.hout = args.out; r.gpost = args.in[11] + DM; break;
  }
  row_phase(r, gw, ngw, lane);
}

__device__ __forceinline__ void do_att(const Args& args, int half, int vcu, unsigned char* lds) {
  unsigned char* ws = args.ws; const float2* CS = (const float2*)(ws + WS_CS); const int G = gridDim.x;
  for (int u = vcu; u < 2048; u += G) {
    const int bh = u >> 4, qb = u & 15, bl = bh >> 4, h = bh & 15; const int bglob = half * 8 + bl;
    att::attn_unit(WSB(WS_QH) + ((size_t)bl * SEQ + qb * 256) * 3072 + h * 192, WSB(WS_KVH) + (size_t)bl * SEQ * 4096 + h * 256, WSB(WS_KR) + (size_t)bglob * SEQ * 64,
                   CS + ((size_t)bglob * SEQ + qb * 256) * 32, WSB(WS_A) + ((size_t)bglob * SEQ + qb * 256) * 2048 + h * 128, SEQ, (char*)lds);
  }
}

__device__ __forceinline__ void do_p0(const Args& args, int gw, int ngw, int lane, int wave, unsigned char* lds) {
  unsigned char* ws = args.ws;
  float* scr = (float*)lds + wave * (64 * 33);
  int base = 0;
#define TRG(SRC, KK, NN, DST, GK) do { const int items = ((KK) / 64) * ((NN) / 32); int first = (gw - base) % ngw; if (first < 0) first += ngw; \
    for (int it = first; it < items; it += ngw) transpose_item((SRC), (KK), (NN), WSB(DST), scr, it, lane, (GK)); base += items; } while (0)
#define TR(SRC, KK, NN, DST) TRG(SRC, KK, NN, DST, nullptr)
  TRG(args.in[13], 1024, 5120, W_HGIN, args.in[3]); TR(args.in[15], 1024, 1024, W_HGOUT);
  TRG(args.in[7], 1024, 4096, W_UP, args.in[5]); TRG(args.in[7] + (size_t)DM * DFF, 1024, 4096, W_UP + 8 * MiB, args.in[5] + DM);
  TR(args.in[8], 4096, 1024, W_DN); TR(args.in[8] + (size_t)DM * DFF, 4096, 1024, W_DN + 8 * MiB);
  TR(args.in[9], 256, 1024, W_PP); TR(args.in[9] + 256 * DM, 256, 1024, W_PP + 512 * 1024);
  TR(args.in[10], 1024, 1024, W_PG); TR(args.in[10] + (size_t)DM * DM, 1024, 1024, W_PG + 2 * MiB);
  TRG(args.in[16], 1024, 704, W_MLAIN, args.in[3] + DM); TR(args.in[18], 384, 3072, W_UQ); TR(args.in[20], 256, 4096, W_UKV); TR(args.in[21], 2048, 1024, W_O);
#undef TR
#undef TRG
  for (int i = gw * 64 + lane; i < 64 * 1024 / 8; i += ngw * 64) *(u32x4*)(WSB(W_MLAIN) + (size_t)704 * 1024 + (size_t)i * 8) = (u32x4){0u, 0u, 0u, 0u};
  if (blockIdx.x == 0) { float* lbv = (float*)(ws + WS_LB); for (int c = threadIdx.x; c < 1024; c += 512) { const float* L = args.in[12]; const float l0 = L[c], l1 = L[1024 + c], l2 = L[2048 + c]; const float mx = fmaxf(l0, fmaxf(l1, l2));
      const float e0 = __expf(l0 - mx), e1 = __expf(l1 - mx), e2 = __expf(l2 - mx); lbv[c] = e0 / (e0 + e1 + e2); } }
  { float2* CS = (float2*)(ws + WS_CS); const int* positions = (const int*)args.in[2];
    for (int i = gw * 64 + lane; i < NT_ * 32; i += ngw * 64) { const int row = i >> 5, fi = i & 31;
      const float inv = 1.0f / exp2f((float)fi * (13.287712379549449f / 32.f)); const float ang = (float)positions[row] * inv;
      double rev = (double)ang * 0.15915494309189535; rev -= floor(rev); const float rf = (float)rev;
      CS[i] = make_float2(__builtin_amdgcn_cosf(rf), __builtin_amdgcn_sinf(rf)); } }
  RowOp r0; r0.rsout = (float*)(ws + WS_RS); r0.hin16 = nullptr; r0.hout16 = nullptr; r0.hin = args.in[0]; r0.m = nullptr; r0.part = nullptr; r0.gpost = nullptr; r0.hout = nullptr; r0.aout = (bf16_t*)args.out; r0.gnext = nullptr;     r0.pin = nullptr; r0.p16 = nullptr;
  row_phase(r0, gw, ngw, lane);
}

__global__ void __launch_bounds__(512, 2) mega(Args args) {
  extern __shared__ __attribute__((aligned(16))) unsigned char lds[];
  cg::grid_group grid = cg::this_grid();
  const int lo = args.ph_lo, hi = args.ph_hi;
  if (lo < 0) grid.sync();
  { volatile LAS unsigned* st0 = (volatile LAS unsigned*)((LAS unsigned char*)lds + XB_LDS_OFF); if (threadIdx.x < 4) st0[threadIdx.x] = 0u; }
  __syncthreads();
  XcdBarrier xbar = xcd_barrier_post((unsigned*)(args.ws + WS_CTL), (volatile LAS unsigned*)((LAS unsigned char*)lds + XB_LDS_OFF));
#define IN(k) (lo <= (k) && (k) < hi)
#define SEAM(k) do { if ((k) + 1 < hi) { xcd_barrier(xbar); } } while (0)
#define FRAME const int tid = threadIdx.x, lane = tid & 63, wave = __builtin_amdgcn_readfirstlane(tid >> 6); const int G = gridDim.x, bx = blockIdx.x; \
    const int vcu = (G % 8 == 0) ? (bx % 8) * (G / 8) + bx / 8 : bx; const int gw = vcu * 8 + wave, ngw = G * 8; unsigned char* ws = args.ws; float* part = (float*)(ws + WS_PART); (void)lane; (void)gw; (void)ngw; (void)part; (void)ws;
#define ROWOP(k) if (IN(k)) { FRAME do_row(args, (k), gw, ngw, lane); SEAM(k); }
  if (IN(0)) { FRAME do_p0(args, gw, ngw, lane, wave, lds);
#ifdef DBL_P0
    __syncthreads(); do_p0(args, gw, ngw, lane, wave, lds);
#endif
    SEAM(0); }
  if (IN(1)) { FRAME gemm_t<NT_, 5120, 1024, 7>((const bf16_t*)args.out, WSB(W_HGIN), WSB(WS_BIG0), nullptr, (float*)(ws + WS_RS), lds); SEAM(1); }
  if (IN(2)) { FRAME for (int rep = 0; rep < SCAN_REPS; ++rep) for (int c = vcu; c < 256; c += G) gla::scan_chain(WSB(WS_BIG0), (const float*)(ws + WS_LB), WSB(WS_A), WSB(WS_B), c, (char*)lds); SEAM(2); }
  if (IN(3)) { FRAME comb_phase(WSB(WS_A), WSB(WS_B), WSB(WS_BIG0), args.in[14], gw, ngw, lane); SEAM(3); }
  if (IN(4)) { FRAME gemm_t<NT_, 1024, 1024, 2>(WSB(WS_A), WSB(W_HGOUT), WSB(WS_B), nullptr, part, lds); SEAM(4); }
  if (IN(5)) { FRAME do_row(args, 5, gw, ngw, lane);
#ifdef DBL_ROW5
    do_row(args, 5, gw, ngw, lane);
#endif
    SEAM(5); }
  if (IN(6)) { FRAME gemm_t<NT_, 4096, 1024, 6>((const bf16_t*)args.out, WSB(W_UP), WSB(WS_HID), nullptr, (float*)(ws + WS_RS), lds); SEAM(6); }
  if (IN(7)) { FRAME gemm_t<NT_, 1024, 4096, 2>(WSB(WS_HID), WSB(W_DN), WSB(WS_B), nullptr, part, lds); }
  if (IN(8)) { FRAME gemm_t<NT_, 1024, 256, 0>(WSB(WS_P16), WSB(W_PP), WSB(WS_BIG0), nullptr, part, lds); SEAM(8); }
  ROWOP(9)
  if (IN(10)) { FRAME gemm_t<NT_, 1024, 1024, 3>((const bf16_t*)args.out, WSB(W_PG), WSB(WS_B), WSB(WS_BIG0), part, lds); SEAM(10); }
  ROWOP(11)
  if (IN(12)) { FRAME gemm_t<NT_, 768, 1024, 7>((const bf16_t*)args.out, WSB(W_MLAIN), WSB(WS_B), nullptr, (float*)(ws + WS_RS), lds); SEAM(12); }
  if (IN(13)) { FRAME rn_phase(WSB(WS_B), args.in[17], args.in[19], (const float2*)(ws + WS_CS), WSB(WS_CQ), WSB(WS_CKV), WSB(WS_KR), gw, ngw, lane); SEAM(13); }
  if (IN(14)) { FRAME gemm_t<32768, 3072, 384, 0>(WSB(WS_CQ), WSB(W_UQ), WSB(WS_QH), nullptr, part, lds); }
  if (IN(15)) { FRAME gemm_t<32768, 4096, 256, 0>(WSB(WS_CKV), WSB(W_UKV), WSB(WS_KVH), nullptr, part, lds); SEAM(15); }
  if (IN(16)) { FRAME do_att(args, 0, vcu, lds);
#ifdef DBL_ATT
    do_att(args, 0, vcu, lds);
#endif
    SEAM(16); }
  if (IN(17)) { FRAME gemm_t<32768, 3072, 384, 0>(WSB(WS_CQ) + (size_t)32768 * 384, WSB(W_UQ), WSB(WS_QH), nullptr, part, lds); }
  if (IN(18)) { FRAME gemm_t<32768, 4096, 256, 0>(WSB(WS_CKV) + (size_t)32768 * 256, WSB(W_UKV), WSB(WS_KVH), nullptr, part, lds); SEAM(18); }
  if (IN(19)) { FRAME do_att(args, 1, vcu, lds);
#ifdef DBL_ATT
    do_att(args, 1, vcu, lds);
#endif
    SEAM(19); }
  if (IN(20)) { FRAME gemm_t<NT_, 1024, 2048, 2>(WSB(WS_A), WSB(W_O), WSB(WS_M3), nullptr, part, lds); SEAM(20); }
  ROWOP(21)
  if (IN(22)) { FRAME gemm_t<NT_, 4096, 1024, 6>((const bf16_t*)args.out, WSB(W_UP + 8 * MiB), WSB(WS_HID), nullptr, (float*)(ws + WS_RS), lds); SEAM(22); }
  if (IN(23)) { FRAME gemm_t<NT_, 1024, 4096, 2>(WSB(WS_HID), WSB(W_DN + 8 * MiB), WSB(WS_B), nullptr, part, lds); }
  if (IN(24)) { FRAME gemm_t<NT_, 1024, 256, 0>(WSB(WS_P16), WSB(W_PP + 512 * 1024), WSB(WS_A), nullptr, part, lds); SEAM(24); }
  ROWOP(25)
  if (IN(26)) { FRAME gemm_t<NT_, 1024, 1024, 3>(WSB(WS_BIG0), WSB(W_PG + 2 * MiB), WSB(WS_B), WSB(WS_A), part, lds); SEAM(26); }
  ROWOP(27)
#ifdef DUMP_MODE
  { FRAME asm volatile("s_waitcnt vmcnt(0) lgkmcnt(0)" ::: "memory"); __builtin_amdgcn_fence(__ATOMIC_RELEASE, "agent"); grid.sync(); __builtin_amdgcn_fence(__ATOMIC_ACQUIRE, "agent");
    for (size_t i = (size_t)bx * 512 + tid; i < (size_t)NT_ * DM; i += (size_t)G * 512) { const size_t row = i >> 10, c = i & 1023; float v = 0.f;
      if (DUMP_MODE == 1) v = bf_lo(WSB(WS_A)[i]);
      else if (DUMP_MODE == 2) { for (int j = 0; j < 5; ++j) v += bf_lo(WSB(WS_BIG0)[row * 5120 + c + 1024 * j]); }
      else if (DUMP_MODE == 3) v = bf_lo(WSB(WS_A)[i]) + bf_lo(WSB(WS_B)[i]);
      else if (DUMP_MODE == 4) v = bf_lo(WSB(WS_B)[i]);
      if (!(fabsf(v) < 1e30f)) v = 12345.f;
      args.out[i] = v; } }
#endif
#undef IN
#undef SEAM
#undef FRAME
#undef ROWOP
}
#undef WSB

#ifndef N_LAUNCH_MODE
#define N_LAUNCH_MODE 0
#endif
extern "C" void kernel_launch(void* const* d_in, const int* in_sizes, int n_in, void* d_out, int out_size, void* d_ws, size_t ws_size, hipStream_t stream) {
  static int grid = 0;
  if (grid == 0) {
    if (n_in != 22 || out_size != NT_ * DM || ws_size < WS_NEED) { fprintf(stderr, "kernel_launch: unexpected shapes n_in %d out %d ws %zu\n", n_in, out_size, ws_size); grid = -1; return; }
    int dev = 0, cus = 0, per_cu = 0;
    hipGetDevice(&dev); hipDeviceGetAttribute(&cus, hipDeviceAttributeMultiprocessorCount, dev);
    if (hipFuncSetAttribute((const void*)mega, hipFuncAttributeMaxDynamicSharedMemorySize, LDS_BYTES) != hipSuccess) { fprintf(stderr, "kernel_launch: hipFuncSetAttribute failed\n"); grid = -1; return; }
    if (hipOccupancyMaxActiveBlocksPerMultiprocessor(&per_cu, (const void*)mega, 512, LDS_BYTES) != hipSuccess || per_cu < 1) { fprintf(stderr, "kernel_launch: occupancy query gives %d\n", per_cu); per_cu = 1; }
    (void)hipGetLastError();
    grid = cus * 1;
  }
  if (grid < 0) return;
  Args a{};
  for (int i = 0; i < 22; ++i) a.in[i] = (const float*)d_in[i];
  a.out = (float*)d_out; a.ws = (unsigned char*)d_ws;
  if (hipMemsetAsync((char*)d_ws + WS_CTL, 0, CTL_BYTES, stream) != hipSuccess) { fprintf(stderr, "kernel_launch: memset failed\n"); return; }
#if N_LAUNCH_MODE == 0
#ifndef STOP_AT
#define STOP_AT N_OPS
#endif
  a.ph_lo = 0; a.ph_hi = STOP_AT;
  void* kargs[] = {&a};
  hipError_t e = hipLaunchCooperativeKernel((const void*)mega, dim3(grid), dim3(512), kargs, LDS_BYTES, stream);
  if (e != hipSuccess) fprintf(stderr, "cooperative launch failed: %s (grid %d)\n", hipGetErrorString(e), grid);
#else
  const int cuts[] = {0, 1, 2, 3, 4, 5, 6, 7, 9, 10, 11, 12, 13, 14, 16, 17, 19, 20, 21, 22, 23, 25, 26, 27, 28};
  for (unsigned i = 0; i + 1 < sizeof(cuts) / sizeof(int); ++i) { a.ph_lo = cuts[i]; a.ph_hi = cuts[i + 1]; hipLaunchKernelGGL(mega, dim3(grid), dim3(512), LDS_BYTES, stream, a); }
#endif
}
```
